# Optimizing an MI355X kernel written in HIP

```python
import jax, jax.numpy as jnp
from jax import lax
import numpy as np

D_MODEL = 1024
BATCH = 8
SEQ = 8192
DEPTH = 4

N_META = 16
N_MIXERS = 2
N_ATTN_LAYERS = (DEPTH + N_MIXERS - 1) // N_MIXERS
N_REC_LAYERS = DEPTH // N_MIXERS
HEAD_DIM = 128
N_Q_HEADS = D_MODEL // HEAD_DIM
N_KV_HEADS = 2
GROUP = N_Q_HEADS // N_KV_HEADS
ATTN_IN = (N_Q_HEADS + 2 * N_KV_HEADS) * HEAD_DIM
WINDOW = 128
ATTN_BLOCK = 128
ROPE_THETA = 10000.0
REC_HEAD_DIM = 128
N_REC_HEADS = D_MODEL // REC_HEAD_DIM
REC_IN = 5 * D_MODEL
REC_CHUNK = 64
D_FF = 4 * D_MODEL
EPS = 1e-6

kernel_name = "hybrid_swa_hgrn2_meta_encoder"


def rms_norm(x, w):
    xf = x.astype(jnp.float32)
    y = xf * lax.rsqrt(jnp.mean(xf * xf, axis=-1, keepdims=True) + EPS) * w.astype(jnp.float32)
    return y.astype(x.dtype)


def rope_tables(length):
    inv_freq = ROPE_THETA ** (-jnp.arange(0, HEAD_DIM, 2, dtype=jnp.float32) / HEAD_DIM)
    ang = jnp.arange(length, dtype=jnp.float32)[:, None] * inv_freq[None, :]
    return jnp.cos(ang), jnp.sin(ang)


def apply_rope(x, cos, sin):
    xf = x.astype(jnp.float32)
    x1, x2 = jnp.split(xf, 2, axis=-1)
    c = cos[None, :, None, :]
    s = sin[None, :, None, :]
    return jnp.concatenate([x1 * c - x2 * s, x2 * c + x1 * s], axis=-1).astype(x.dtype)


def band_blocks(t, nb):
    tp = jnp.pad(t, ((0, 0), (ATTN_BLOCK, ATTN_BLOCK), (0, 0), (0, 0)))
    tb = tp.reshape(t.shape[0], nb + 2, ATTN_BLOCK, t.shape[2], t.shape[3])
    return jnp.concatenate([tb[:, :-2], tb[:, 1:-1], tb[:, 2:]], axis=2)


def band_mask(nb):
    a = jnp.arange(ATTN_BLOCK)[None, :, None]
    c = jnp.arange(3 * ATTN_BLOCK)[None, None, :]
    n = jnp.arange(nb)[:, None, None]
    key_idx = (n - 1) * ATTN_BLOCK + c
    rel = c - ATTN_BLOCK - a
    return (jnp.abs(rel) <= WINDOW) & (key_idx >= 0) & (key_idx < nb * ATTN_BLOCK)


def window_gqa_attention(h, w_in, w_out, q_gain, k_gain, sink, cos, sin):
    B, L, _ = h.shape
    S = L - N_META
    nb = S // ATTN_BLOCK
    qkv = h @ w_in
    q, k, v = jnp.split(qkv, [N_Q_HEADS * HEAD_DIM, (N_Q_HEADS + N_KV_HEADS) * HEAD_DIM], axis=-1)
    q = q.reshape(B, L, N_Q_HEADS, HEAD_DIM)
    k = k.reshape(B, L, N_KV_HEADS, HEAD_DIM)
    v = v.reshape(B, L, N_KV_HEADS, HEAD_DIM)
    q = apply_rope(rms_norm(q, q_gain), cos, sin) * (HEAD_DIM ** -0.5)
    k = apply_rope(rms_norm(k, k_gain), cos, sin)
    q = q.reshape(B, L, N_KV_HEADS, GROUP, HEAD_DIM)
    qm, qr = q[:, :N_META], q[:, N_META:]
    km, kr = k[:, :N_META], k[:, N_META:]
    vm, vr = v[:, :N_META], v[:, N_META:]
    sink_l = sink.astype(jnp.float32).reshape(N_KV_HEADS, GROUP)
    nk = 3 * ATTN_BLOCK

    qb = qr.reshape(B, nb, ATTN_BLOCK, N_KV_HEADS, GROUP, HEAD_DIM)
    kw = band_blocks(kr, nb)
    vw = band_blocks(vr, nb)
    s_band = jnp.einsum('bnqhgd,bnkhd->bnhgqk', qb, kw, preferred_element_type=jnp.float32)
    s_band = jnp.where(band_mask(nb)[None, :, None, None], s_band, -jnp.inf)
    s_meta = jnp.einsum('bnqhgd,bmhd->bnhgqm', qb, km, preferred_element_type=jnp.float32)
    s_sink = jnp.broadcast_to(sink_l[None, None, :, :, None, None], s_meta.shape[:-1] + (1,))
    p = jax.nn.softmax(jnp.concatenate([s_band, s_meta, s_sink], axis=-1), axis=-1)
    p_band = p[..., :nk].astype(v.dtype)
    p_meta = p[..., nk:nk + N_META].astype(v.dtype)
    o_r = (jnp.einsum('bnhgqk,bnkhd->bnqhgd', p_band, vw)
           + jnp.einsum('bnhgqm,bmhd->bnqhgd', p_meta, vm)).reshape(B, S, D_MODEL)

    kmw = jnp.concatenate([km, kr[:, :ATTN_BLOCK]], axis=1)
    vmw = jnp.concatenate([vm, vr[:, :ATTN_BLOCK]], axis=1)
    q_pos = jnp.arange(N_META)[:, None]
    k_pos = jnp.arange(N_META + ATTN_BLOCK)[None, :]
    mask_m = (k_pos < N_META) | (k_pos - q_pos <= WINDOW)
    s_m = jnp.einsum('bqhgd,bkhd->bhgqk', qm, kmw, preferred_element_type=jnp.float32)
    s_m = jnp.where(mask_m[None, None, None], s_m, -jnp.inf)
    s_m_sink = jnp.broadcast_to(sink_l[None, :, :, None, None], s_m.shape[:-1] + (1,))
    p_m = jax.nn.softmax(jnp.concatenate([s_m, s_m_sink], axis=-1), axis=-1)[..., :-1].astype(v.dtype)
    o_m = jnp.einsum('bhgqk,bkhd->bqhgd', p_m, vmw).reshape(B, N_META, D_MODEL)

    o = jnp.concatenate([o_m, o_r], axis=1)
    return o @ w_out


def gla_chunk_step(state, xs):
    q, k, v, g = xs
    G = jnp.cumsum(g, axis=2)
    G_last = G[:, :, -1:, :]
    o_inter = jnp.einsum('bhtd,bhde->bhte', q * jnp.exp(G), state)
    C = q.shape[2]
    lower = jnp.arange(C)[:, None] >= jnp.arange(C)[None, :]
    diff = jnp.where(lower[None, None, :, :, None], G[:, :, :, None, :] - G[:, :, None, :, :], -jnp.inf)
    A = jnp.einsum('bhtd,bhsd,bhtsd->bhts', q, k, jnp.exp(diff))
    o_intra = jnp.einsum('bhts,bhse->bhte', A, v)
    new_state = (state * jnp.exp(G_last)[:, :, 0, :, None]
                 + jnp.einsum('bhsd,bhse->bhde', k * jnp.exp(G_last - G), v))
    return new_state, o_inter + o_intra


def chunk_scan(q, k, v, g):
    nc, B, H, C, dk = q.shape
    state0 = jnp.zeros((B, H, dk, v.shape[-1]), jnp.float32)
    _, o = lax.scan(gla_chunk_step, state0, (q, k, v, g))
    return o


def lower_bound(table, layer):
    p = jax.nn.softmax(table.astype(jnp.float32), axis=0)
    cs = jnp.cumsum(p, axis=0)
    return cs[layer] - cs[0]


def hgrn2_bidirectional(h, w_in, w_out, lb_fwd_table, lb_bwd_table, o_gain, layer):
    B, L, _ = h.shape
    pad = REC_CHUNK - N_META
    P = L + pad
    nc = P // REC_CHUNK
    proj = h @ w_in
    zq, zi, zf_f, zf_b, zg = jnp.split(proj, 5, axis=-1)
    q = jax.nn.silu(zq.astype(jnp.float32))
    v = zi.astype(jnp.float32)

    def forget(z, table):
        lb = lower_bound(table, layer)
        f = lb + (1.0 - lb) * jax.nn.sigmoid(z.astype(jnp.float32))
        return jnp.log(f), 1.0 - f

    g_f, k_f = forget(zf_f, lb_fwd_table)
    g_b, k_b = forget(zf_b, lb_bwd_table)

    def to_chunks(t):
        t = jnp.pad(t, ((0, 0), (pad, 0), (0, 0)))
        t = t.reshape(B, nc, REC_CHUNK, N_REC_HEADS, REC_HEAD_DIM)
        return t.transpose(1, 0, 3, 2, 4)

    qc, vc = to_chunks(q), to_chunks(v)
    o_f = chunk_scan(qc, to_chunks(k_f), vc, to_chunks(g_f))
    flip = lambda t: jnp.flip(t, axis=(0, 3))
    o_b = flip(chunk_scan(flip(qc), flip(to_chunks(k_b)), flip(vc), flip(to_chunks(g_b))))
    o = (o_f + o_b).transpose(1, 0, 3, 2, 4).reshape(B, P, N_REC_HEADS, REC_HEAD_DIM)[:, pad:]
    o = rms_norm(o, o_gain).reshape(B, L, D_MODEL)
    o = (o * jax.nn.silu(zg.astype(jnp.float32))).astype(h.dtype)
    return o @ w_out


def sq_relu_mlp(h, w_up, w_down):
    z = jax.nn.relu(h @ w_up)
    return (z * z) @ w_down


def setup_inputs(seed: int = 0) -> dict:
    key = jax.random.key(seed)
    ks = jax.random.split(key, 16)
    nrm = lambda k, shape, scale: jax.random.normal(k, shape, jnp.float32) * scale
    return {
        "x": nrm(ks[0], (BATCH, SEQ, D_MODEL), 1.0),
        "meta_tokens": nrm(ks[1], (N_META, D_MODEL), 1.0),
        "mix_norm_w": 1.0 + nrm(ks[2], (DEPTH, D_MODEL), 0.02),
        "mlp_norm_w": 1.0 + nrm(ks[3], (DEPTH, D_MODEL), 0.02),
        "attn_w_in": nrm(ks[4], (N_ATTN_LAYERS, D_MODEL, ATTN_IN), D_MODEL ** -0.5),
        "attn_w_out": nrm(ks[5], (N_ATTN_LAYERS, N_Q_HEADS * HEAD_DIM, D_MODEL), (N_Q_HEADS * HEAD_DIM) ** -0.5),
        "attn_q_norm_w": 1.0 + nrm(ks[6], (N_ATTN_LAYERS, HEAD_DIM), 0.02),
        "attn_k_norm_w": 1.0 + nrm(ks[7], (N_ATTN_LAYERS, HEAD_DIM), 0.02),
        "attn_sink": nrm(ks[8], (N_ATTN_LAYERS, N_Q_HEADS), 0.5),
        "rec_w_in": nrm(ks[9], (N_REC_LAYERS, D_MODEL, REC_IN), D_MODEL ** -0.5),
        "rec_w_out": nrm(ks[10], (N_REC_LAYERS, D_MODEL, D_MODEL), D_MODEL ** -0.5),
        "rec_lb_fwd": nrm(ks[11], (DEPTH, D_MODEL), 0.5),
        "rec_lb_bwd": nrm(ks[12], (DEPTH, D_MODEL), 0.5),
        "rec_out_norm_w": 1.0 + nrm(ks[13], (N_REC_LAYERS, REC_HEAD_DIM), 0.02),
        "mlp_w_up": nrm(ks[14], (DEPTH, D_MODEL, D_FF), D_MODEL ** -0.5),
        "mlp_w_down": nrm(ks[15], (DEPTH, D_FF, D_MODEL), D_FF ** -0.5),
    }


def reference(x, meta_tokens, mix_norm_w, mlp_norm_w, attn_w_in, attn_w_out, attn_q_norm_w,
              attn_k_norm_w, attn_sink, rec_w_in, rec_w_out, rec_lb_fwd, rec_lb_bwd,
              rec_out_norm_w, mlp_w_up, mlp_w_down):
    B = x.shape[0]
    meta = jnp.broadcast_to(meta_tokens.astype(x.dtype)[None], (B, N_META, D_MODEL))
    h = jnp.concatenate([meta, x], axis=1)
    cos, sin = rope_tables(h.shape[1])
    for layer in range(DEPTH):
        j = layer // N_MIXERS
        hn = rms_norm(h, mix_norm_w[layer])
        if layer % N_MIXERS == 0:
            h = h + window_gqa_attention(hn, attn_w_in[j], attn_w_out[j], attn_q_norm_w[j],
                                         attn_k_norm_w[j], attn_sink[j], cos, sin)
        else:
            h = h + hgrn2_bidirectional(hn, rec_w_in[j], rec_w_out[j], rec_lb_fwd, rec_lb_bwd,
                                        rec_out_norm_w[j], layer)
        h = h + sq_relu_mlp(rms_norm(h, mlp_norm_w[layer]), mlp_w_up[layer], mlp_w_down[layer])
    return h[:, N_META:]
```

```cpp
#include <hip/hip_runtime.h>
#include <hip/hip_cooperative_groups.h>
#include <cstdio>
namespace cg = cooperative_groups;

#define DBG_SRC OFF_OB
#define PROBE_REP_SCAN 1
#define PROBE_REP_ATTN 1
#define LAS __attribute__((address_space(3)))
typedef unsigned short bf16_t;
typedef short bf16x8 __attribute__((ext_vector_type(8)));
typedef float f32x4 __attribute__((ext_vector_type(4)));
typedef float f32x2 __attribute__((ext_vector_type(2)));
typedef unsigned u32x4 __attribute__((ext_vector_type(4)));
typedef unsigned u32x2 __attribute__((ext_vector_type(2)));

constexpr int DM = 1024, NB = 8, SEQ = 8192, NMETA = 16;
constexpr int MREAL = NB * SEQ;
constexpr int MROWS = MREAL + NB * NMETA;
constexpr int MP = 65792;
constexpr int NTHR = 512;
constexpr int LDS_BYTES = 140 * 1024;
constexpr float EPS = 1e-6f;

constexpr size_t OFF_SQP = 0;
constexpr size_t OFF_LB = OFF_SQP + (size_t)MP * 16 * 4;
constexpr size_t OFF_ROPE = OFF_LB + 4 * 2 * 1024 * 4;
constexpr size_t OFF_HMETA = OFF_ROPE + (size_t)8208 * 64 * 8;
constexpr size_t OFF_WT = OFF_HMETA + (size_t)256 * 1024 * 4;
constexpr size_t WT_ELEMS = 51380224;
constexpr size_t OFF_HB = OFF_WT + WT_ELEMS * 2;
constexpr size_t OFF_OB = OFF_HB + (size_t)MP * 1024 * 2;
constexpr size_t OFF_BIG = OFF_OB + (size_t)MP * 1024 * 2;
constexpr size_t OFF_BAR = OFF_BIG + (size_t)MP * 5120 * 2;
constexpr size_t WS_END = OFF_BAR + 256;
static_assert(OFF_WT % 256 == 0 && OFF_HB % 256 == 0 && OFF_BIG % 256 == 0, "align");
__host__ __device__ constexpr size_t WT_AIN(int j) { return (size_t)j * 1536 * 1024; }
__host__ __device__ constexpr size_t WT_AOUT(int j) { return 3145728 + (size_t)j * 1048576; }
__host__ __device__ constexpr size_t WT_RIN(int j) { return 5242880 + (size_t)j * 5242880; }
__host__ __device__ constexpr size_t WT_ROUT(int j) { return 15728640 + (size_t)j * 1048576; }
__host__ __device__ constexpr size_t WT_UP(int l) { return 17825792 + (size_t)l * 4194304; }
__host__ __device__ constexpr size_t WT_DN(int l) { return 34603008 + (size_t)l * 4194304; }
constexpr size_t BIG_QP = (size_t)MP * 1536;
constexpr size_t BIG_KP = BIG_QP + (size_t)MP * 1024;
constexpr size_t BIG_VTR = BIG_KP + (size_t)MP * 256;
constexpr size_t BIG_VTM = BIG_VTR + (size_t)NB * 2 * 128 * SEQ;

struct Params {
    const float* x; const float* meta; const float* mixw; const float* mlpw; const float* awin; const float* awout;
    const float* aqn; const float* akn; const float* asink; const float* rwin; const float* rwout; const float* lbf;
    const float* lbb; const float* rog; const float* wup; const float* wdn;
    float* out; unsigned char* ws; int ph_lo, ph_hi;
};

typedef __bf16 bf16v2 __attribute__((ext_vector_type(2)));
__device__ __forceinline__ unsigned cvt_pk_bf16(float lo, float hi) { const f32x2 v = {lo, hi}; return __builtin_bit_cast(unsigned, __builtin_convertvector(v, bf16v2)); }
__device__ __forceinline__ int tid_of(int wv) { int l; asm volatile("v_mbcnt_lo_u32_b32 %0, -1, 0\n\tv_mbcnt_hi_u32_b32 %0, -1, %0" : "=v"(l)); return wv * 64 + l; }
__device__ __forceinline__ float shx(float v, int lane, int mask) { return __int_as_float(__builtin_amdgcn_ds_bpermute((lane ^ mask) << 2, __float_as_int(v))); }
__device__ __forceinline__ float bflo(unsigned w) { return __uint_as_float(w << 16); }
__device__ __forceinline__ float bfhi(unsigned w) { return __uint_as_float(w & 0xffff0000u); }
__device__ __forceinline__ float silu_f(float v) { return v * __builtin_amdgcn_rcpf(1.0f + __expf(-v)); }

namespace pg8 {
constexpr int BM = 256, BK = 64, HALF = 128, HTB = HALF * BK * 2, STAGE_BYTES = 8 * HTB, NXCD = 8, WGM = 8;
__host__ __device__ __forceinline__ int lds_byte(int r, int c) { const int st = (r >> 4) * 2 + (c >> 5), rr = r & 15, cc = c & 31, ob = rr * 64 + cc * 2; return st * 1024 + (ob ^ (((ob >> 9) & 1) << 5)); }
__host__ __device__ __forceinline__ void stage_rc(int b, int& R, int& C) { const int st = b / 1024, sb = b % 1024, swz = sb ^ (((sb >> 9) & 1) << 5); R = (st >> 1) * 16 + swz / 64; C = (st & 1) * 32 + (swz % 64) / 2; }
__host__ __device__ __forceinline__ int perm32(int rho) { const int n = rho >> 4, i = rho & 15; return 8 * (i >> 2) + 4 * n + (i & 3); }
struct Unit { int pm, pn; };
struct Gemm { const bf16_t* A; const bf16_t* Bt; int M, N, K; };
struct StaticOrder {
    int nM, nN, nwg, G, c, rev;
    __device__ void init(int M, int N, int G_, int c_, int rev_ = 0) { nM = M / BM; nN = N / BM; nwg = nM * nN; G = G_; c = c_; rev = rev_; }
    __device__ bool next(int i, Unit& u) const {
        const long L = (long)i * G + c; if (L >= nwg) return false;
        int wgid = (int)L; { const int q = nwg / NXCD, r = nwg % NXCD, xcd = wgid % NXCD, off = wgid / NXCD; wgid = (xcd < r ? xcd * (q + 1) : r * (q + 1) + (xcd - r) * q) + off; }
        const int nig = WGM * nN, gid = wgid / nig, fm = gid * WGM, gsz = (nM - fm) < WGM ? (nM - fm) : WGM;
        u.pm = fm + ((wgid % nig) % gsz); u.pn = (wgid % nig) / gsz; if (rev) u.pm = nM - 1 - u.pm; return true;
    }
};

template <class Epi>
__device__ __forceinline__ void gemm_phase(LAS unsigned char* lds, const Gemm g, const StaticOrder& S, const Epi& E, int wv) {
    const int tid = tid_of(wv), wid = __builtin_amdgcn_readfirstlane(tid >> 6), lane = tid & 63, wr = wid >> 2, wc = wid & 3, fr = lane & 15, fq = lane >> 4;
    const int K = g.K, nt = K / BK;
    unsigned voffA[2], voffB[2];
#pragma unroll
    for (int i = 0; i < 2; ++i) { int R, C; stage_rc(tid * 16 + i * 8192, R, C); const int Rb = Epi::PERM ? ((R & ~31) + perm32(R & 31)) : R;
        voffA[i] = (unsigned)(R * K + C) * 2u; voffB[i] = (unsigned)(Rb * K + C) * 2u; }
    const size_t kstep = (size_t)(BK * 2);
    const size_t hstep = (size_t)HALF * K * 2;
    const size_t tstep = 2 * hstep;
    const unsigned ldsw = (unsigned)wid * 1024u;
    const int aoff = lds_byte(wr * 64 + fr, fq * 8), boff = lds_byte(wc * 32 + fr, fq * 8);
#define PG8_SA(b, h) (((b) * 2 + (h)) * HTB)
#define PG8_SB(b, h) ((4 + (b) * 2 + (h)) * HTB)
#define PG8_STAGE(bufoff, gbase, voff) do { _Pragma("unroll") for (int _i = 0; _i < 2; ++_i) \
        __builtin_amdgcn_global_load_lds((const unsigned*)((const char*)(gbase) + (voff)[_i]), (LAS unsigned*)(lds + (bufoff) + ldsw + _i * 8192), 16, 0, 0); } while (0)
#define PG8_LDA(dst, b, h) do { _Pragma("unroll") for (int m = 0; m < 4; ++m) _Pragma("unroll") for (int k = 0; k < 2; ++k) dst[m][k] = *(const LAS bf16x8*)(lds + PG8_SA(b, h) + aoff + m * 2048 + k * 1024); } while (0)
#define PG8_LDB(dst, b, h) do { _Pragma("unroll") for (int n = 0; n < 2; ++n) _Pragma("unroll") for (int k = 0; k < 2; ++k) dst[n][k] = *(const LAS bf16x8*)(lds + PG8_SB(b, h) + boff + n * 2048 + k * 1024); } while (0)
#define PG8_MMA(ai, bj, At, Bt) do { __builtin_amdgcn_s_setprio(1); _Pragma("unroll") for (int m = 0; m < 4; ++m) _Pragma("unroll") for (int n = 0; n < 2; ++n) _Pragma("unroll") for (int k = 0; k < 2; ++k) \
        acc[ai][bj][m][n] = __builtin_amdgcn_mfma_f32_16x16x32_bf16(Bt[n][k], At[m][k], acc[ai][bj][m][n], 0, 0, 0); __builtin_amdgcn_s_setprio(0); } while (0)
#define PG8_WAIT_V(n) asm volatile("s_waitcnt vmcnt(" #n ")" ::: "memory")
#define PG8_WAIT_L(n) asm volatile("s_waitcnt lgkmcnt(" #n ")" ::: "memory")
#define PG8_BAR __builtin_amdgcn_s_barrier()
#define PG8_SCHED __builtin_amdgcn_sched_barrier(0)
    Unit cur, nxt; int ui = 0;
    if (!S.next(0, cur)) return;
    f32x4 acc[2][2][4][2];
#pragma unroll
    for (int a = 0; a < 2; ++a)
#pragma unroll
        for (int b = 0; b < 2; ++b)
#pragma unroll
            for (int m = 0; m < 4; ++m)
#pragma unroll
                for (int n = 0; n < 2; ++n) acc[a][b][m][n] = (f32x4){0.f, 0.f, 0.f, 0.f};
    bf16x8 At[4][2], B0[2][2], B1[2][2];
    const char* cA = (const char*)g.A + (size_t)cur.pm * tstep; const char* cB = (const char*)g.Bt + (size_t)cur.pn * tstep;
    PG8_STAGE(PG8_SB(0, 0), cB, voffB); PG8_STAGE(PG8_SB(0, 1), cB + hstep, voffB); PG8_STAGE(PG8_SA(0, 0), cA, voffA); PG8_STAGE(PG8_SA(0, 1), cA + hstep, voffA);
    if (wr == 1) PG8_BAR;
    PG8_WAIT_V(2); PG8_BAR;
    PG8_STAGE(PG8_SB(1, 0), cB + kstep, voffB); PG8_STAGE(PG8_SA(1, 0), cA + kstep, voffA); PG8_STAGE(PG8_SB(1, 1), cB + hstep + kstep, voffB);
    PG8_WAIT_V(6); PG8_BAR;
    for (;;) {
        const bool has_next = S.next(ui + 1, nxt);
        const char* nA = has_next ? (const char*)g.A + (size_t)nxt.pm * tstep : cA; const char* nB = has_next ? (const char*)g.Bt + (size_t)nxt.pn * tstep : cB;
        for (int t = 0; t < nt; t += 2) {
            const bool last = (t == nt - 2);
            const char* a1 = cA + (size_t)(t + 1) * kstep;
            const char* a2 = last ? nA : cA + (size_t)(t + 2) * kstep; const char* b2 = last ? nB : cB + (size_t)(t + 2) * kstep;
            const char* a3 = a2 + kstep; const char* b3 = b2 + kstep;
            PG8_LDB(B0, 0, 0); PG8_LDB(B1, 0, 1); PG8_SCHED; PG8_LDA(At, 0, 0); PG8_STAGE(PG8_SA(1, 1), a1 + hstep, voffA);
            PG8_WAIT_V(8); PG8_WAIT_L(0); PG8_BAR; PG8_MMA(0, 0, At, B0); PG8_MMA(0, 1, At, B1); PG8_BAR; PG8_SCHED;
            PG8_LDA(At, 0, 1); PG8_STAGE(PG8_SB(0, 0), b2, voffB); PG8_STAGE(PG8_SB(0, 1), b2 + hstep, voffB); PG8_STAGE(PG8_SA(0, 0), a2, voffA);
            PG8_WAIT_V(8); PG8_WAIT_L(0); PG8_BAR; PG8_MMA(1, 0, At, B0); PG8_MMA(1, 1, At, B1); PG8_BAR; PG8_SCHED;
            PG8_LDB(B0, 1, 0); PG8_LDB(B1, 1, 1); PG8_SCHED; PG8_LDA(At, 1, 0); PG8_STAGE(PG8_SA(0, 1), a2 + hstep, voffA);
            PG8_WAIT_V(8); PG8_WAIT_L(0); PG8_BAR; PG8_MMA(0, 0, At, B0); PG8_MMA(0, 1, At, B1); PG8_BAR; PG8_SCHED;
            PG8_LDA(At, 1, 1); PG8_STAGE(PG8_SB(1, 0), b3, voffB); PG8_STAGE(PG8_SB(1, 1), b3 + hstep, voffB); PG8_STAGE(PG8_SA(1, 0), a3, voffA);
            PG8_WAIT_V(8); PG8_WAIT_L(0); PG8_BAR; PG8_MMA(1, 0, At, B0); PG8_MMA(1, 1, At, B1); PG8_BAR; PG8_SCHED;
        }
        if (wr == 0) PG8_BAR;
        E(acc, cur, wr, wc, fr, fq);
        if (!has_next) break;
#pragma unroll
        for (int a = 0; a < 2; ++a)
#pragma unroll
            for (int b = 0; b < 2; ++b)
#pragma unroll
                for (int m = 0; m < 4; ++m)
#pragma unroll
                    for (int n = 0; n < 2; ++n) acc[a][b][m][n] = (f32x4){0.f, 0.f, 0.f, 0.f};
        cur = nxt; cA = nA; cB = nB; ++ui;
        if (wr == 1) PG8_BAR;
    }
    PG8_WAIT_V(0);
    PG8_BAR;
#undef PG8_SA
#undef PG8_SB
#undef PG8_STAGE
#undef PG8_LDA
#undef PG8_LDB
#undef PG8_MMA
#undef PG8_WAIT_V
#undef PG8_WAIT_L
#undef PG8_BAR
#undef PG8_SCHED
}
}

template <int ACT> struct EpiAct {
    static constexpr bool PERM = true;
    bf16_t* O; int ldc; const float* sq; const float* lbf; const float* lbb;
    __device__ __forceinline__ void operator()(const f32x4 (&acc)[2][2][4][2], const pg8::Unit& u, int wr, int wc, int fr, int fq) const {
        const int row0 = u.pm * 256 + wr * 64 + fr, col0 = u.pn * 256 + wc * 32 + 8 * fq;
        const int sect = (ACT == 2) ? (u.pn >> 2) : 0;
        f32x4 lbv[2][2];
#pragma unroll
        for (int bj = 0; bj < 2; ++bj) { lbv[bj][0] = (f32x4){0.f, 0.f, 0.f, 0.f}; lbv[bj][1] = lbv[bj][0]; }
        if (ACT == 2 && (sect == 2 || sect == 3)) { const float* lb = (sect == 2) ? lbf : lbb;
#pragma unroll
            for (int bj = 0; bj < 2; ++bj) { const int c = (col0 + bj * 128) & 1023; lbv[bj][0] = *(const f32x4*)(lb + c); lbv[bj][1] = *(const f32x4*)(lb + c + 4); } }
        float rsv[8];
        { f32x4 qv[8];
#pragma unroll
          for (int k = 0; k < 8; ++k) qv[k] = *(const f32x4*)(sq + (size_t)(row0 + (k >> 2) * 128 + (k & 3) * 16) * 16 + 4 * fq);
#pragma unroll
          for (int k = 0; k < 8; ++k) { float t = (qv[k][0] + qv[k][1]) + (qv[k][2] + qv[k][3]); t += shx(t, fq * 16 + fr, 16); t += shx(t, fq * 16 + fr, 32); rsv[k] = rsqrtf(t * (1.0f / 1024.0f) + EPS); } }
#pragma unroll
        for (int ai = 0; ai < 2; ++ai)
#pragma unroll
            for (int m = 0; m < 4; ++m) {
                const int row = row0 + ai * 128 + m * 16;
                const float rs = rsv[ai * 4 + m];
                bf16_t* rowp = O + (size_t)row * ldc + col0;
#pragma unroll
                for (int bj = 0; bj < 2; ++bj) {
                    float v[8];
#pragma unroll
                    for (int j = 0; j < 4; ++j) { v[j] = acc[ai][bj][m][0][j] * rs; v[4 + j] = acc[ai][bj][m][1][j] * rs; }
                    if (ACT == 1) {
#pragma unroll
                        for (int j = 0; j < 8; ++j) { const float t = fmaxf(v[j], 0.f); v[j] = t * t; }
                    }
                    if (ACT == 2) {
                        if (sect == 0 || sect == 4) {
#pragma unroll
                            for (int j = 0; j < 8; ++j) v[j] = silu_f(v[j]);
                        } else if (sect >= 2) {
#pragma unroll
                            for (int j = 0; j < 8; ++j) { const float lb = lbv[bj][j >> 2][j & 3]; const float sg = __builtin_amdgcn_rcpf(1.0f + __expf(-v[j])); v[j] = __log2f(lb + (1.0f - lb) * sg); }
                        }
                    }
                    u32x4 w; w.x = cvt_pk_bf16(v[0], v[1]); w.y = cvt_pk_bf16(v[2], v[3]); w.z = cvt_pk_bf16(v[4], v[5]); w.w = cvt_pk_bf16(v[6], v[7]);
                    *(u32x4*)(rowp + bj * 128) = w;
                }
            }
    }
};
struct EpiRes {
    static constexpr bool PERM = false;
    const float* rin; float* hout; float* hmeta; bf16_t* hb; float* sqn;
    __device__ __forceinline__ void operator()(const f32x4 (&acc)[2][2][4][2], const pg8::Unit& u, int wr, int wc, int fr, int fq) const {
        const bool mt = (u.pm == 256);
        const float* rbase = mt ? hmeta : rin; float* obase = mt ? hmeta : hout; const int rowoff = mt ? MREAL : 0;
        const int row0 = u.pm * 256 + wr * 64 + fr, col0 = u.pn * 256 + wc * 32 + 4 * fq;
#pragma unroll
        for (int ai = 0; ai < 2; ++ai)
#pragma unroll
            for (int m = 0; m < 4; ++m) {
                const int row = row0 + ai * 128 + m * 16; const size_t lo = (size_t)(row - rowoff) * 1024 + col0;
                float ss = 0.f;
#pragma unroll
                for (int bj = 0; bj < 2; ++bj)
#pragma unroll
                    for (int n = 0; n < 2; ++n) {
                        const int co = bj * 128 + n * 16;
                        const f32x4 r = *(const f32x4*)(rbase + lo + co); const f32x4 o = r + acc[ai][bj][m][n];
                        __builtin_nontemporal_store(o, (f32x4*)(obase + lo + co));
                        u32x2 w; w.x = cvt_pk_bf16(o[0], o[1]); w.y = cvt_pk_bf16(o[2], o[3]);
                        *(u32x2*)(hb + (size_t)row * 1024 + col0 + co) = w;
                        ss += (o[0] * o[0] + o[1] * o[1]) + (o[2] * o[2] + o[3] * o[3]);
                    }
                ss += shx(ss, fq * 16 + fr, 16); ss += shx(ss, fq * 16 + fr, 32);
                if (fq == 0) sqn[(size_t)row * 16 + u.pn * 4 + wc] = ss;
            }
    }
};

__device__ void transpose_w(const float* __restrict__ W, int K, int N, const float* __restrict__ scale, bf16_t* __restrict__ Wt, LAS float* tile, int wv) {
    const int tid = tid_of(wv); const int ntn = N >> 6, ntk = K >> 6;
    for (int t = blockIdx.x; t < ntn * ntk; t += gridDim.x) {
        const int tk = t / ntn, tn = t % ntn;
#pragma unroll
        for (int j = 0; j < 2; ++j) { const int kk = (tid >> 4) + 32 * j; const f32x4 v = *(const f32x4*)(W + (size_t)(tk * 64 + kk) * N + tn * 64 + (tid & 15) * 4);
            const float s = scale ? scale[tk * 64 + kk] : 1.0f;
#pragma unroll
            for (int i = 0; i < 4; ++i) tile[kk * 65 + (tid & 15) * 4 + i] = v[i] * s; }
        __syncthreads();
        { const int n = tid >> 3, k0 = (tid & 7) * 8; float v[8];
#pragma unroll
            for (int i = 0; i < 8; ++i) v[i] = tile[(k0 + i) * 65 + n];
            u32x4 w; w.x = cvt_pk_bf16(v[0], v[1]); w.y = cvt_pk_bf16(v[2], v[3]); w.z = cvt_pk_bf16(v[4], v[5]); w.w = cvt_pk_bf16(v[6], v[7]);
            *(u32x4*)(Wt + (size_t)(tn * 64 + n) * K + tk * 64 + k0) = w; }
        __syncthreads();
    }
}
__device__ __forceinline__ void sincos_d(double a, float& c, float& s) {
    const double k = rint(a * 0.63661977236758134308); const double r = fma(-k, 1.57079632679489655800, a) - k * 6.123233995736766e-17;
    const double r2 = r * r;
    const double sn = r * (1.0 + r2 * (-1.0 / 6 + r2 * (1.0 / 120 + r2 * (-1.0 / 5040 + r2 * (1.0 / 362880 + r2 * (-1.0 / 39916800 + r2 * (1.0 / 6227020800.0)))))));
    const double cs = 1.0 + r2 * (-0.5 + r2 * (1.0 / 24 + r2 * (-1.0 / 720 + r2 * (1.0 / 40320 + r2 * (-1.0 / 3628800 + r2 * (1.0 / 479001600.0))))));
    const int q = ((int)k) & 3;
    const double sv = (q == 0) ? sn : (q == 1) ? cs : (q == 2) ? -sn : -cs;
    const double cv = (q == 0) ? cs : (q == 1) ? -sn : (q == 2) ? -cs : sn;
    c = (float)cv; s = (float)sv;
}
__device__ void phase_init(const Params& p, LAS unsigned char* lds, int wv) {
    unsigned char* ws = p.ws; bf16_t* WT = (bf16_t*)(ws + OFF_WT); LAS float* tile = (LAS float*)lds;
    const int tid = tid_of(wv), lane = tid & 63, wave = tid >> 6;
    { float* LB = (float*)(ws + OFF_LB);
      for (int i = blockIdx.x * NTHR + tid; i < 2048; i += gridDim.x * NTHR) { const int dir = i >> 10, d = i & 1023; const float* T = dir ? p.lbb : p.lbf;
          const float t0 = T[d], t1 = T[1024 + d], t2 = T[2048 + d], t3 = T[3072 + d]; const float mx = fmaxf(fmaxf(t0, t1), fmaxf(t2, t3));
          const float e0 = expf(t0 - mx), e1 = expf(t1 - mx), e2 = expf(t2 - mx), e3 = expf(t3 - mx); const float inv = 1.0f / (e0 + e1 + e2 + e3);
          const float p1 = e1 * inv, p2 = e2 * inv, p3 = e3 * inv;
          LB[(0 * 2 + dir) * 1024 + d] = 0.f; LB[(1 * 2 + dir) * 1024 + d] = p1; LB[(2 * 2 + dir) * 1024 + d] = p1 + p2; LB[(3 * 2 + dir) * 1024 + d] = p1 + p2 + p3; }
      f32x2* RP = (f32x2*)(ws + OFF_ROPE);
      for (int i = blockIdx.x * NTHR + tid; i < 8208 * 64; i += gridDim.x * NTHR) { const int pos = i >> 6, fi = i & 63;
          const float inv = (float)exp(-(double)fi * (9.210340371976184 / 64.0)); const float ang = (float)pos * inv; float c, s; sincos_d((double)ang, c, s); RP[i] = (f32x2){c, s}; } }
    { bf16_t* HB = (bf16_t*)(ws + OFF_HB); float* SQP = (float*)(ws + OFF_SQP); float* HM = (float*)(ws + OFF_HMETA);
      for (int row = blockIdx.x * 8 + wave; row < MP; row += gridDim.x * 8) {
          const float* src = row < MREAL ? p.x + (size_t)row * 1024 : (row < MROWS ? p.meta + (size_t)((row - MREAL) & 15) * 1024 : nullptr);
          float ss = 0.f;
#pragma unroll
          for (int j = 0; j < 4; ++j) { const int c = j * 256 + lane * 4; f32x4 v = src ? *(const f32x4*)(src + c) : (f32x4){0.f, 0.f, 0.f, 0.f};
              ss += (v[0] * v[0] + v[1] * v[1]) + (v[2] * v[2] + v[3] * v[3]);
              u32x2 w; w.x = cvt_pk_bf16(v[0], v[1]); w.y = cvt_pk_bf16(v[2], v[3]); *(u32x2*)(HB + (size_t)row * 1024 + c) = w;
              if (row >= MREAL) *(f32x4*)(HM + (size_t)(row - MREAL) * 1024 + c) = v; }
#pragma unroll
          for (int o = 32; o >= 1; o >>= 1) ss += shx(ss, lane, o);
          if (lane < 16) SQP[(size_t)row * 16 + lane] = (lane == 0) ? ss : 0.f; } }
    for (int j = 0; j < 2; ++j) {
        transpose_w(p.awin + (size_t)j * 1024 * 1536, 1024, 1536, p.mixw + (2 * j) * 1024, WT + WT_AIN(j), tile, wv);
        transpose_w(p.awout + (size_t)j * 1024 * 1024, 1024, 1024, nullptr, WT + WT_AOUT(j), tile, wv);
        transpose_w(p.rwin + (size_t)j * 1024 * 5120, 1024, 5120, p.mixw + (2 * j + 1) * 1024, WT + WT_RIN(j), tile, wv);
        transpose_w(p.rwout + (size_t)j * 1024 * 1024, 1024, 1024, nullptr, WT + WT_ROUT(j), tile, wv);
    }
    for (int l = 0; l < 4; ++l) {
        transpose_w(p.wup + (size_t)l * 1024 * 4096, 1024, 4096, p.mlpw + l * 1024, WT + WT_UP(l), tile, wv);
        transpose_w(p.wdn + (size_t)l * 4096 * 1024, 4096, 1024, nullptr, WT + WT_DN(l), tile, wv);
    }
}

__device__ void phase_attn_prep(const Params& p, int j, LAS unsigned char* lds, int wv) {
    unsigned char* ws = p.ws; bf16_t* BIG = (bf16_t*)(ws + OFF_BIG);
    const bf16_t* QKV = BIG; bf16_t* Qp = BIG + BIG_QP; bf16_t* Kp = BIG + BIG_KP; bf16_t* VTr = BIG + BIG_VTR; bf16_t* VTm = BIG + BIG_VTM;
    const f32x2* RP = (const f32x2*)(ws + OFF_ROPE); const float* qg = p.aqn + j * 128; const float* kg = p.akn + j * 128;
    LAS bf16_t* tv = (LAS bf16_t*)lds;
    const int tid = tid_of(wv);
    for (int unit = blockIdx.x; unit < MROWS / 64; unit += gridDim.x) {
        const int row0 = unit * 64;
        for (int it0 = 0; it0 < 20; it0 += 4) {
          u32x2 lo4[4], hi4[4];
#pragma unroll
          for (int u = 0; u < 4; ++u) { const int task = (it0 + u) * 32 + (tid >> 4), r = task / 10, hd = task - r * 10, jj = tid & 15; const bf16_t* src = QKV + (size_t)(row0 + r) * 1536 + hd * 128;
              lo4[u] = *(const u32x2*)(src + 4 * jj); hi4[u] = *(const u32x2*)(src + 64 + 4 * jj); }
#pragma unroll
          for (int u = 0; u < 4; ++u) { const int it = it0 + u;
            const int task = it * 32 + (tid >> 4), r = task / 10, hd = task - r * 10, jj = tid & 15;
            const int row = row0 + r; const int pos = row < MREAL ? NMETA + (row & (SEQ - 1)) : ((row - MREAL) & 15);
            const u32x2 lo = lo4[u], hi = hi4[u];
            float x1[4] = {bflo(lo.x), bfhi(lo.x), bflo(lo.y), bfhi(lo.y)}, x2[4] = {bflo(hi.x), bfhi(hi.x), bflo(hi.y), bfhi(hi.y)};
            float ss = 0.f;
#pragma unroll
            for (int i = 0; i < 4; ++i) ss += x1[i] * x1[i] + x2[i] * x2[i];
            ss += shx(ss, tid & 63, 1); ss += shx(ss, tid & 63, 2); ss += shx(ss, tid & 63, 4); ss += shx(ss, tid & 63, 8);
            const float rs = rsqrtf(ss * (1.0f / 128.0f) + EPS);
            const float* gw = hd < 8 ? qg : kg; const float sc = hd < 8 ? 0.08838834764831845f * 1.4426950408889634f : 1.0f;
            const f32x4 g1 = *(const f32x4*)(gw + 4 * jj), g2 = *(const f32x4*)(gw + 64 + 4 * jj);
            float o1[4], o2[4];
#pragma unroll
            for (int i = 0; i < 4; ++i) { const f32x2 cs = RP[pos * 64 + 4 * jj + i]; const float y1 = x1[i] * rs * g1[i], y2 = x2[i] * rs * g2[i];
                o1[i] = (y1 * cs.x - y2 * cs.y) * sc; o2[i] = (y2 * cs.x + y1 * cs.y) * sc; }
            bf16_t* dst = hd < 8 ? Qp + (size_t)row * 1024 + hd * 128 : Kp + (size_t)row * 256 + (hd - 8) * 128;
            u32x2 w1, w2; w1.x = cvt_pk_bf16(o1[0], o1[1]); w1.y = cvt_pk_bf16(o1[2], o1[3]); w2.x = cvt_pk_bf16(o2[0], o2[1]); w2.y = cvt_pk_bf16(o2[2], o2[3]);
            *(u32x2*)(dst + 4 * jj) = w1; *(u32x2*)(dst + 64 + 4 * jj) = w2;
          }
        }
        { const int r = tid >> 3, c0 = (tid & 7) * 32; const bf16_t* src = QKV + (size_t)(row0 + r) * 1536 + 1280 + c0;
#pragma unroll
          for (int q = 0; q < 4; ++q) { const u32x4 v = *(const u32x4*)(src + q * 8); LAS unsigned* d = (LAS unsigned*)(tv + r * 258 + c0 + q * 8); d[0] = v.x; d[1] = v.y; d[2] = v.z; d[3] = v.w; } }
        __syncthreads();
#pragma unroll
        for (int it = 0; it < 4; ++it) { const int id = it * NTHR + tid, col = id >> 3, ch = id & 7; unsigned short e[8];
#pragma unroll
            for (int i = 0; i < 8; ++i) e[i] = tv[(ch * 8 + i) * 258 + col];
            u32x4 w; w.x = e[0] | ((unsigned)e[1] << 16); w.y = e[2] | ((unsigned)e[3] << 16); w.z = e[4] | ((unsigned)e[5] << 16); w.w = e[6] | ((unsigned)e[7] << 16);
            const int row = row0 + ch * 8, hkv = col >> 7, d = col & 127;
            bf16_t* dst; if (row < MREAL) { const int b = row >> 13, s = row & (SEQ - 1); dst = VTr + ((size_t)((b * 2 + hkv) * 128 + d)) * SEQ + s; }
            else { const int rr = row - MREAL, b = rr >> 4, m = rr & 15; dst = VTm + ((size_t)((b * 2 + hkv) * 128 + d)) * 16 + m; }
            *(u32x4*)dst = w; }
        __syncthreads();
    }
}

__device__ void phase_attn(const Params& p, int j, LAS unsigned char* lds, int wv) {
    unsigned char* ws = p.ws; bf16_t* BIG = (bf16_t*)(ws + OFF_BIG);
    const bf16_t* Qp = BIG + BIG_QP; const bf16_t* Kp = BIG + BIG_KP; const bf16_t* VTr = BIG + BIG_VTR; const bf16_t* VTm = BIG + BIG_VTM;
    bf16_t* OB = (bf16_t*)(ws + OFF_OB);
    constexpr int KSTR = 272, VSTR = 848;
    const int tid = tid_of(wv), w = __builtin_amdgcn_readfirstlane(tid >> 6), lane = tid & 63, m16 = lane & 15, g = lane >> 4;
    for (int item = blockIdx.x; item < 4096 + 64; item += gridDim.x) {
        int hq, b, n; bool real;
        if (item < 4096) { real = true;
            if (gridDim.x == 256) {
                const int c = item & 255, kvg = (item >> 8) * 64 + (c & 7) * 8 + (c >> 5); hq = ((kvg >> 6) & 1) * 4 + ((c >> 3) & 3); n = kvg & 63; b = kvg >> 7;
            } else { hq = item & 7; n = (item >> 3) & 63; b = item >> 9; } }
        else { const int mi = item - 4096; hq = mi & 7; b = mi >> 3; n = 0; real = false; }
        const int hkv = hq >> 2; const int t0 = real ? (n - 1) * 128 : 0; const int nbg = real ? 12 : 4;
        const int mlo = real ? 0 : -1000000, mhi = real ? 256 : 112;
        const float sinkv = p.asink[j * 8 + hq] * 1.4426950408889634f;
        { u32x4 kb[13];
          const int c = (tid >> 4) & 31, jj = tid & 15, j8 = c >> 3, q = c & 7; const int lpos = (q < 4 ? 4 * j8 + q : 16 + 4 * j8 + (q - 4));
#pragma unroll
          for (int it = 0; it < 13; ++it) {
              const int slot = it * 32 + c; bool ok; const bf16_t* src;
              if (it < 12) { const int tok = t0 + slot; ok = (it < nbg) && tok >= 0 && tok < SEQ; src = Kp + (size_t)(b * SEQ + (ok ? tok : 0)) * 256 + hkv * 128 + 8 * jj; }
              else { ok = c < 16; src = Kp + (size_t)(MREAL + b * 16 + (c & 15)) * 256 + hkv * 128 + 8 * jj; }
              const u32x4 v = *(const u32x4*)src; kb[it] = ok ? v : (u32x4){0u, 0u, 0u, 0u};
          }
#pragma unroll
          for (int it = 0; it < 13; ++it) *(LAS u32x4*)(lds + (it * 32 + lpos) * KSTR + jj * 16) = kb[it];
        }
        const bool active = real || (w == 0);
        const int qrow = real ? b * SEQ + n * 128 + 16 * w + m16 : MREAL + b * 16 + m16;
        bf16x8 qf[4];
#pragma unroll
        for (int ks = 0; ks < 4; ++ks) qf[ks] = *(const bf16x8*)(Qp + (size_t)qrow * 1024 + hq * 128 + 32 * ks + 8 * g);
        __syncthreads();
        float s[13][8];
        const int a = real ? 16 * w + m16 : m16;
#pragma unroll
        for (int grp = 0; grp < 13; ++grp) {
            const bool use = active && ((grp < nbg && (!real || (grp * 32 + 31 >= 16 * w && grp * 32 <= 16 * w + 15 + 256))) || grp == 12);
            if (use) {
                f32x4 c0 = (f32x4){0.f, 0.f, 0.f, 0.f}, c1 = c0;
#pragma unroll
                for (int ks = 0; ks < 4; ++ks) {
                    const bf16x8 a0 = *(const LAS bf16x8*)(lds + (grp * 32 + m16) * KSTR + (32 * ks + 8 * g) * 2);
                    const bf16x8 a1 = *(const LAS bf16x8*)(lds + (grp * 32 + 16 + m16) * KSTR + (32 * ks + 8 * g) * 2);
                    c0 = __builtin_amdgcn_mfma_f32_16x16x32_bf16(a0, qf[ks], c0, 0, 0, 0);
                    c1 = __builtin_amdgcn_mfma_f32_16x16x32_bf16(a1, qf[ks], c1, 0, 0, 0);
                }
                const bool full = real && n >= 1 && n <= 62 && grp < 12 && (grp * 32 >= 16 * w + 15) && (grp * 32 + 31 <= 16 * w + 256);
#pragma unroll
                for (int r = 0; r < 8; ++r) {
                    const int c = 8 * g + r; const float v = r < 4 ? c0[r & 3] : c1[r & 3]; bool ok;
                    if (full) { s[grp][r] = v; continue; }
                    if (grp < 12) { const int slot = grp * 32 + c, tok = t0 + slot, rel = slot - a; ok = (tok >= 0) && (tok < SEQ) && (rel >= mlo) && (rel <= mhi); }
                    else ok = c < 16;
                    s[grp][r] = ok ? v : -1e30f;
                }
            } else {
#pragma unroll
                for (int r = 0; r < 8; ++r) s[grp][r] = -1e30f;
            }
        }
        float mx = sinkv;
#pragma unroll
        for (int grp = 0; grp < 13; ++grp)
#pragma unroll
            for (int r = 0; r < 8; ++r) mx = fmaxf(mx, s[grp][r]);
        mx = fmaxf(mx, shx(mx, lane, 16)); mx = fmaxf(mx, shx(mx, lane, 32));
        float sum = 0.f;
#pragma unroll
        for (int grp = 0; grp < 13; ++grp)
#pragma unroll
            for (int r = 0; r < 8; ++r) { const float e = __builtin_amdgcn_exp2f(s[grp][r] - mx); s[grp][r] = e; sum += e; }
        sum += shx(sum, lane, 16); sum += shx(sum, lane, 32);
        sum += __builtin_amdgcn_exp2f(sinkv - mx);
        const float inv = 1.0f / sum;
        bf16x8 pk[13];
#pragma unroll
        for (int grp = 0; grp < 13; ++grp) { u32x4 t; t.x = cvt_pk_bf16(s[grp][0], s[grp][1]); t.y = cvt_pk_bf16(s[grp][2], s[grp][3]);
            t.z = cvt_pk_bf16(s[grp][4], s[grp][5]); t.w = cvt_pk_bf16(s[grp][6], s[grp][7]); pk[grp] = __builtin_bit_cast(bf16x8, t); }
        __syncthreads();
#pragma unroll
        for (int hb = 0; hb < 2; ++hb) { u32x4 vb[7]; int t5 = tid; asm volatile("" : "+v"(t5));
#pragma unroll
          for (int i7 = 0; i7 < 7; ++i7) { const int it = hb * 7 + i7; if (it < 13) {
              const int id = it * NTHR + t5, d = id / 52, cc = id - d * 52; bool ok; const bf16_t* src;
              const size_t rowb = (size_t)((b * 2 + hkv) * 128 + d);
              if (cc < 48) { const int tok = t0 + cc * 8; ok = ((cc >> 2) < nbg) && tok >= 0 && tok < SEQ; src = VTr + rowb * SEQ + (ok ? tok : 0); }
              else { ok = cc < 50; src = VTm + rowb * 16 + (cc & 1) * 8; }
              const u32x4 v = *(const u32x4*)src; vb[i7] = ok ? v : (u32x4){0u, 0u, 0u, 0u}; } }
#pragma unroll
          for (int i7 = 0; i7 < 7; ++i7) { const int it = hb * 7 + i7; if (it < 13) { const int id = it * NTHR + t5, d = id / 52, cc = id - d * 52; *(LAS u32x4*)(lds + d * VSTR + cc * 16) = vb[i7]; } }
          asm volatile("" ::: "memory");
        }
        __syncthreads();
        if (active) {
            f32x4 o[8];
#pragma unroll
            for (int dt = 0; dt < 8; ++dt) o[dt] = (f32x4){0.f, 0.f, 0.f, 0.f};
#pragma unroll
            for (int grp = 0; grp < 13; ++grp) {
                if ((grp < nbg && (!real || (grp * 32 + 31 >= 16 * w && grp * 32 <= 16 * w + 15 + 256))) || grp == 12) {
#pragma unroll
                    for (int dt = 0; dt < 8; ++dt) { const bf16x8 av = *(const LAS bf16x8*)(lds + (16 * dt + m16) * VSTR + (grp * 32 + 8 * g) * 2);
                        o[dt] = __builtin_amdgcn_mfma_f32_16x16x32_bf16(av, pk[grp], o[dt], 0, 0, 0); }
                }
            }
            bf16_t* dst = OB + (size_t)qrow * 1024 + hq * 128 + 4 * g;
#pragma unroll
            for (int dt = 0; dt < 8; ++dt) { u32x2 wv; wv.x = cvt_pk_bf16(o[dt][0] * inv, o[dt][1] * inv); wv.y = cvt_pk_bf16(o[dt][2] * inv, o[dt][3] * inv); *(u32x2*)(dst + 16 * dt) = wv; }
        }
        __syncthreads();
    }
}

typedef short bf16x4 __attribute__((ext_vector_type(4)));
#define SC_BAR() do { asm volatile("s_waitcnt lgkmcnt(0)" ::: "memory"); __builtin_amdgcn_s_barrier(); asm volatile("" ::: "memory"); } while (0)
__device__ void phase_scan(const Params& p, LAS unsigned char* lds, int wv) {
    unsigned char* ws = p.ws; const bf16_t* P = (const bf16_t*)(ws + OFF_BIG); bf16_t* OF = (bf16_t*)(ws + OFF_HB); bf16_t* OBk = (bf16_t*)(ws + OFF_OB);
    const int tid = tid_of(wv), w = wv, lane = tid & 63, m16 = lane & 15, g = lane >> 4;
    constexpr int NCH = 1 + SEQ / 16, RING = 4, SLOT = 10240;
    constexpr int QSTR = 272, TSTR = 40, OSTR = 144;
    constexpr int OPB = 2 * 16 * QSTR + 128 * TSTR + 512;
    LAS unsigned char* QH = lds;
    LAS unsigned char* ABUF = lds + 2 * OPB + (w & 3) * 512;
    LAS unsigned char* OBUF0 = lds + 2 * OPB + 4 * 512;
    LAS unsigned char* RINGB = OBUF0 + 2 * 16 * OSTR;
    for (int item = blockIdx.x; item < 256; item += gridDim.x) {
        int half, rest;
        if (gridDim.x == 256) { const int sidx = item >> 3; half = sidx & 1; rest = (sidx >> 1) * 8 + (item & 7); } else { half = item & 1; rest = item >> 1; }
        const int dir = rest & 1, h = (rest >> 1) & 7, b = rest >> 4, dvb = 64 * half;
        bf16_t* dstb = dir ? OBk : OF;
        f32x4 S[8]; bf16x4 Sb[8];
#pragma unroll
        for (int j = 0; j < 8; ++j) { S[j] = (f32x4){0.f, 0.f, 0.f, 0.f}; Sb[j] = (bf16x4){0, 0, 0, 0}; }
        auto chunk_base = [&](int ci) { const bool meta = dir ? (ci == NCH - 1) : (ci == 0); return meta ? MREAL + b * 16 : b * SEQ + (dir ? (NCH - 2 - ci) : (ci - 1)) * 16; };
        auto issue = [&](int ci) { LAS unsigned char* sl = RINGB + (ci & (RING - 1)) * SLOT; const int cb = chunk_base(ci);
            if (w >= 4) {
#pragma unroll
                for (int i = 0; i < 2; ++i) { const int blk = (w - 4) * 2 + i, a = blk >> 2, tok = (blk & 3) * 4 + (lane >> 4); const int row = cb + (dir ? 15 - tok : tok);
                    const int coff = (a == 0) ? 0 : 2048 + dir * 1024;
                    __builtin_amdgcn_global_load_lds((const unsigned*)(P + (size_t)row * 5120 + h * 128 + coff + 8 * (lane & 15)), (LAS unsigned*)(sl + a * 4096 + (blk & 3) * 1024), 16, 0, 0); }
            } else if (w < 2) { const int tok = 8 * w + (lane >> 3); const int row = cb + (dir ? 15 - tok : tok);
                __builtin_amdgcn_global_load_lds((const unsigned*)(P + (size_t)row * 5120 + 1024 + h * 128 + dvb + 8 * (lane & 7)), (LAS unsigned*)(sl + 8192 + w * 1024), 16, 0, 0); } };
        auto store_out = [&](int cprev) { if (w == 2 || w == 3) { const LAS unsigned char* ob = OBUF0 + (cprev & 1) * 16 * OSTR; const int cb = chunk_base(cprev);
            const int sp = (w - 2) * 64 + lane, stok = sp >> 3, slj = sp & 7; const u32x4 ov = *(const LAS u32x4*)(ob + stok * OSTR + slj * 16);
            const int row = cb + (dir ? 15 - stok : stok); *(u32x4*)(dstb + (size_t)row * 1024 + h * 128 + dvb + 8 * slj) = ov; } };
        auto prep = [&](int cn) { const LAS unsigned char* RQn = RINGB + (cn & (RING - 1)) * SLOT; const LAS unsigned char* RGn = RQn + 4096;
            LAS unsigned char* QHn = QH + (cn & 1) * OPB; LAS unsigned char* KTn = QHn + 16 * QSTR; LAS unsigned char* KTTn = KTn + 16 * QSTR; LAS float* DECn = (LAS float*)(KTTn + 128 * TSTR);
            const int pt = tid - 256, dkp = pt & 63, tg = pt >> 6, dk = 2 * dkp;
            const int pos = (dk & ~31) + 8 * ((dk >> 2) & 3) + 4 * ((dk >> 4) & 1) + (dk & 3);
            float G0 = 0.f, G1 = 0.f;
            { unsigned gp[12];
#pragma unroll
              for (int t = 0; t < 12; ++t) gp[t] = *(const LAS unsigned*)(RGn + (t * 128 + dk) * 2);
#pragma unroll
              for (int t = 0; t < 12; ++t) { G0 += (t < 4 * tg) ? bflo(gp[t]) : 0.f; G1 += (t < 4 * tg) ? bfhi(gp[t]) : 0.f; } }
            float E0 = __builtin_amdgcn_exp2f(G0), E1 = __builtin_amdgcn_exp2f(G1);
            unsigned k0[4], k1[4];
#pragma unroll
            for (int i = 0; i < 4; ++i) { const int t = 4 * tg + i; const unsigned gw = *(const LAS unsigned*)(RGn + (t * 128 + dk) * 2), qw = *(const LAS unsigned*)(RQn + (t * 128 + dk) * 2);
                const float g0 = bflo(gw), g1 = bfhi(gw); G0 += g0; G1 += g1;
                const float f0 = __builtin_amdgcn_exp2f(g0), f1 = __builtin_amdgcn_exp2f(g1); E0 *= f0; E1 *= f1;
                const float qh0 = bflo(qw) * E0, qh1 = bfhi(qw) * E1;
                const float kt0 = (1.0f - f0) * __builtin_amdgcn_exp2f(fminf(-G0, 115.0f)), kt1 = (1.0f - f1) * __builtin_amdgcn_exp2f(fminf(-G1, 115.0f));
                const unsigned pq = cvt_pk_bf16(qh0, qh1), pk = cvt_pk_bf16(kt0, kt1);
                *(LAS unsigned*)(QHn + t * QSTR + pos * 2) = pq; *(LAS unsigned*)(KTn + t * QSTR + pos * 2) = pk; k0[i] = pk & 0xffffu; k1[i] = pk >> 16; }
            u32x2 kw0, kw1; kw0.x = k0[0] | (k0[1] << 16); kw0.y = k0[2] | (k0[3] << 16); kw1.x = k1[0] | (k1[1] << 16); kw1.y = k1[2] | (k1[3] << 16);
            *(LAS u32x2*)(KTTn + dk * TSTR + tg * 8) = kw0; *(LAS u32x2*)(KTTn + (dk + 1) * TSTR + tg * 8) = kw1;
            if (tg == 3) *(LAS f32x2*)(DECn + dk) = (f32x2){E0, E1}; };
        issue(0); issue(1); issue(2);
        if (w >= 4) asm volatile("s_waitcnt vmcnt(4)" ::: "memory");
        SC_BAR();
        if (w >= 4) prep(0);
        for (int ci = 0; ci < NCH; ++ci) {
            if (w >= 4 || w < 2) { if (ci + 2 < NCH) asm volatile("s_waitcnt vmcnt(2)" ::: "memory"); else asm volatile("s_waitcnt vmcnt(0)" ::: "memory"); }
            SC_BAR();
            if (ci > 0) store_out(ci - 1);
            if (ci + 3 < NCH) issue(ci + 3);
            if (w < 4) {
              const LAS unsigned char* RV = RINGB + (ci & (RING - 1)) * SLOT + 8192;
              LAS unsigned char* OBUF = OBUF0 + (ci & 1) * 16 * OSTR;
              LAS unsigned char* QHc = QH + (ci & 1) * OPB; LAS unsigned char* KTc = QHc + 16 * QSTR; LAS unsigned char* KTTc = KTc + 16 * QSTR; LAS float* DECc = (LAS float*)(KTTc + 128 * TSTR);
              bf16x8 qa[4]; f32x4 am = (f32x4){0.f, 0.f, 0.f, 0.f};
#pragma unroll
              for (int ks = 0; ks < 4; ++ks) { qa[ks] = *(const LAS bf16x8*)(QHc + m16 * QSTR + (32 * ks + 8 * g) * 2); const bf16x8 kb = *(const LAS bf16x8*)(KTc + m16 * QSTR + (32 * ks + 8 * g) * 2);
                  am = __builtin_amdgcn_mfma_f32_16x16x32_bf16(qa[ks], kb, am, 0, 0, 0); }
#pragma unroll
              for (int r = 0; r < 4; ++r) { const float v = (m16 <= 4 * g + r) ? am[r] : 0.f; const unsigned pv = cvt_pk_bf16(v, 0.f); *(LAS bf16_t*)(ABUF + (4 * g + r) * 32 + m16 * 2) = (bf16_t)(pv & 0xffffu); }
              const bf16x4 aa = *(const LAS bf16x4*)(ABUF + m16 * 32 + 8 * g);
              bf16x4 vb;
              { unsigned e[4];
#pragma unroll
                for (int i = 0; i < 4; ++i) e[i] = *(const LAS bf16_t*)(RV + ((4 * g + i) * 64 + 16 * w + m16) * 2);
                u32x2 vw; vw.x = e[0] | (e[1] << 16); vw.y = e[2] | (e[3] << 16); vb = __builtin_bit_cast(bf16x4, vw); }
              f32x4 o = (f32x4){0.f, 0.f, 0.f, 0.f};
#pragma unroll
              for (int ks = 0; ks < 4; ++ks) { const bf16x8 sb = __builtin_shufflevector(Sb[2 * ks], Sb[2 * ks + 1], 0, 1, 2, 3, 4, 5, 6, 7); o = __builtin_amdgcn_mfma_f32_16x16x32_bf16(qa[ks], sb, o, 0, 0, 0); }
              o = __builtin_amdgcn_mfma_f32_16x16x16bf16_1k(aa, vb, o, 0, 0, 0);
#pragma unroll
              for (int j = 0; j < 8; ++j) { const bf16x4 ka = *(const LAS bf16x4*)(KTTc + (16 * j + m16) * TSTR + 8 * g); S[j] = __builtin_amdgcn_mfma_f32_16x16x16bf16_1k(ka, vb, S[j], 0, 0, 0);
                  const f32x4 dc = *(const LAS f32x4*)(DECc + 16 * j + 4 * g); S[j] = S[j] * dc;
                  u32x2 sw; sw.x = cvt_pk_bf16(S[j][0], S[j][1]); sw.y = cvt_pk_bf16(S[j][2], S[j][3]); Sb[j] = __builtin_bit_cast(bf16x4, sw); }
#pragma unroll
              for (int r = 0; r < 4; ++r) { const unsigned pv = cvt_pk_bf16(o[r], 0.f); *(LAS bf16_t*)(OBUF + (4 * g + r) * OSTR + (16 * w + m16) * 2) = (bf16_t)(pv & 0xffffu); }
            } else if (ci + 1 < NCH) prep(ci + 1);
        }
        asm volatile("s_waitcnt vmcnt(0)" ::: "memory"); SC_BAR();
        store_out(NCH - 1);
        SC_BAR();
    }
}
__device__ void phase_rec_fin(const Params& p, int j, int wv) {
    unsigned char* ws = p.ws; const bf16_t* P = (const bf16_t*)(ws + OFF_BIG); const bf16_t* OF = (const bf16_t*)(ws + OFF_HB); bf16_t* OBk = (bf16_t*)(ws + OFF_OB);
    const float* og = p.rog + j * 128;
    const int tid = tid_of(wv), lj = tid & 15;
    const f32x4 g0 = *(const f32x4*)(og + 8 * lj), g1 = *(const f32x4*)(og + 8 * lj + 4);
    constexpr int NT = MROWS * 8;
    for (int task0 = blockIdx.x * 32 + (tid >> 4); task0 < NT; task0 += gridDim.x * 32 * 4) {
        u32x4 av[4], bv[4], sv4[4];
#pragma unroll
        for (int u = 0; u < 4; ++u) { const int task = task0 + u * gridDim.x * 32; const int tk = task < NT ? task : task0; const int row = tk >> 3, h = tk & 7; const size_t off = (size_t)row * 1024 + h * 128 + 8 * lj;
            av[u] = *(const u32x4*)(OF + off); bv[u] = *(const u32x4*)(OBk + off); sv4[u] = *(const u32x4*)(P + (size_t)row * 5120 + 4096 + h * 128 + 8 * lj); }
#pragma unroll
        for (int u = 0; u < 4; ++u) { const int task = task0 + u * gridDim.x * 32; if (task < NT) { const int row = task >> 3, h = task & 7; const size_t off = (size_t)row * 1024 + h * 128 + 8 * lj;
            const unsigned aa[4] = {av[u].x, av[u].y, av[u].z, av[u].w}, bb[4] = {bv[u].x, bv[u].y, bv[u].z, bv[u].w}, ss4[4] = {sv4[u].x, sv4[u].y, sv4[u].z, sv4[u].w};
            float x[8], sv[8]; float ss = 0.f;
#pragma unroll
            for (int i = 0; i < 4; ++i) { x[2 * i] = bflo(aa[i]) + bflo(bb[i]); x[2 * i + 1] = bfhi(aa[i]) + bfhi(bb[i]); sv[2 * i] = bflo(ss4[i]); sv[2 * i + 1] = bfhi(ss4[i]); ss += x[2 * i] * x[2 * i] + x[2 * i + 1] * x[2 * i + 1]; }
            ss += shx(ss, tid & 63, 1); ss += shx(ss, tid & 63, 2); ss += shx(ss, tid & 63, 4); ss += shx(ss, tid & 63, 8);
            const float rs = rsqrtf(ss * (1.0f / 128.0f) + EPS);
            float y[8];
#pragma unroll
            for (int i = 0; i < 8; ++i) y[i] = x[i] * rs * (i < 4 ? g0[i & 3] : g1[i & 3]) * sv[i];
            u32x4 wv4; wv4.x = cvt_pk_bf16(y[0], y[1]); wv4.y = cvt_pk_bf16(y[2], y[3]); wv4.z = cvt_pk_bf16(y[4], y[5]); wv4.w = cvt_pk_bf16(y[6], y[7]);
            *(u32x4*)(OBk + off) = wv4; } }
    }
}

__device__ __forceinline__ void fast_barrier(unsigned* ctr, unsigned& gen) {
    asm volatile("s_waitcnt vmcnt(0) lgkmcnt(0)" ::: "memory");
    __syncthreads();
    ++gen;
    if (threadIdx.x == 0) {
        __builtin_amdgcn_fence(__ATOMIC_RELEASE, "agent");
        asm volatile("s_waitcnt vmcnt(0)" ::: "memory");
        const unsigned target = gen * gridDim.x;
        (void)__hip_atomic_fetch_add(ctr, 1u, __ATOMIC_RELAXED, __HIP_MEMORY_SCOPE_AGENT);
        unsigned spins = 0;
        while (__hip_atomic_load(ctr, __ATOMIC_RELAXED, __HIP_MEMORY_SCOPE_AGENT) < target) { __builtin_amdgcn_s_sleep(1); if (++spins > (1u << 24)) break; }
        __builtin_amdgcn_fence(__ATOMIC_ACQUIRE, "agent");
        asm volatile("s_waitcnt vmcnt(0)" ::: "memory");
    }
    __syncthreads();
}

__device__ __forceinline__ void zero_f32(float* ptr, int n) { for (int i = blockIdx.x * NTHR + threadIdx.x; i < n; i += gridDim.x * NTHR) ptr[i] = 0.f; }

constexpr int NPHASE = 25;
__global__ void __launch_bounds__(NTHR, 2) fwd_kernel(Params p) {
    extern __shared__ __attribute__((aligned(16))) unsigned char lds_raw[];
    LAS unsigned char* lds = (LAS unsigned char*)lds_raw;
    cg::grid_group grid = cg::this_grid();
    const int wv = __builtin_amdgcn_readfirstlane(threadIdx.x >> 6);
    unsigned char* ws = p.ws;
    bf16_t* WT = (bf16_t*)(ws + OFF_WT); bf16_t* HB = (bf16_t*)(ws + OFF_HB); bf16_t* OB = (bf16_t*)(ws + OFF_OB); bf16_t* BIG = (bf16_t*)(ws + OFF_BIG);
    float* SQP = (float*)(ws + OFF_SQP); float* HM = (float*)(ws + OFF_HMETA); const float* LB = (const float*)(ws + OFF_LB);
    unsigned* BARC = (unsigned*)(ws + OFF_BAR); unsigned bgen = 0;
    int ph0 = p.ph_lo;
    if (p.ph_lo < 0) grid.sync();
    if (ph0 == 0) { phase_init(p, lds, wv); ph0 = 1; if (ph0 < p.ph_hi) fast_barrier(BARC, bgen); }
    for (int ph = ph0; ph < p.ph_hi; ++ph) {
        {
            const int L = (ph - 1) / 6, sub = (ph - 1) % 6, j = L >> 1; const bool isattn = !(L & 1);
            pg8::StaticOrder S;
            if (sub == 0) {
                if (isattn) { pg8::Gemm g{HB, WT + WT_AIN(j), MP, 1536, 1024}; S.init(MP, 1536, gridDim.x, blockIdx.x); EpiAct<0> E{BIG, 1536, SQP, nullptr, nullptr}; pg8::gemm_phase<EpiAct<0>>(lds, g, S, E, wv); }
                else { pg8::Gemm g{HB, WT + WT_RIN(j), MP, 5120, 1024}; S.init(MP, 5120, gridDim.x, blockIdx.x); EpiAct<2> E{BIG, 5120, SQP, LB + (L * 2 + 0) * 1024, LB + (L * 2 + 1) * 1024}; pg8::gemm_phase<EpiAct<2>>(lds, g, S, E, wv); }
            } else if (sub == 1) { if (isattn) phase_attn_prep(p, j, lds, wv); else {
#pragma unroll 1
                    for (int rep = 0; rep < PROBE_REP_SCAN; ++rep) { if (rep) grid.sync(); phase_scan(p, lds, wv); } } }
            else if (sub == 2) { if (isattn) {
#pragma unroll 1
                    for (int rep = 0; rep < PROBE_REP_ATTN; ++rep) { if (rep) grid.sync(); phase_attn(p, j, lds, wv); } } else phase_rec_fin(p, j, wv); }
            else if (sub == 4) {
                pg8::Gemm g{HB, WT + WT_UP(L), MP, 4096, 1024}; S.init(MP, 4096, gridDim.x, blockIdx.x); EpiAct<1> E{BIG, 4096, SQP, nullptr, nullptr}; pg8::gemm_phase<EpiAct<1>>(lds, g, S, E, wv);
            } else {
                const bf16_t* A = (sub == 3) ? OB : BIG; const bf16_t* Bt = (sub == 3) ? (isattn ? WT + WT_AOUT(j) : WT + WT_ROUT(j)) : WT + WT_DN(L);
                const int K = (sub == 3) ? 1024 : 4096;
                pg8::Gemm g{A, Bt, MP, 1024, K}; S.init(MP, 1024, gridDim.x, blockIdx.x, sub == 5);
                EpiRes E{(ph == 4) ? p.x : p.out, p.out, HM, HB, SQP};
                pg8::gemm_phase<EpiRes>(lds, g, S, E, wv);
            }
        }
        if (ph + 1 < p.ph_hi) fast_barrier(BARC, bgen);
    }
#ifdef DBG_STOP
    grid.sync();
    { const bf16_t* HBs = (const bf16_t*)(ws + DBG_SRC);
      for (size_t i = (size_t)blockIdx.x * NTHR + threadIdx.x; i < (size_t)MREAL * 1024; i += (size_t)gridDim.x * NTHR) p.out[i] = __uint_as_float(((unsigned)HBs[i]) << 16); }
#endif
}

#ifndef N_LAUNCH_MODE
#define N_LAUNCH_MODE 1
#endif
extern "C" void kernel_launch(void* const* d_in, const int* in_sizes, int n_in, void* d_out, int out_size, void* d_ws, size_t ws_size, hipStream_t stream) {
    static int grid = 0;
    if (grid == 0) {
        if (n_in != 16 || ws_size < WS_END) { fprintf(stderr, "kernel_launch: need 16 inputs and %zu bytes of workspace (got %d, %zu)\n", (size_t)WS_END, n_in, ws_size); grid = -1; return; }
        int dev = 0, cus = 0, per_cu = 0;
        (void)hipGetDevice(&dev); (void)hipDeviceGetAttribute(&cus, hipDeviceAttributeMultiprocessorCount, dev);
        if (hipFuncSetAttribute((const void*)fwd_kernel, hipFuncAttributeMaxDynamicSharedMemorySize, LDS_BYTES) != hipSuccess) { fprintf(stderr, "kernel_launch: hipFuncSetAttribute failed\n"); grid = -1; return; }
        if (hipOccupancyMaxActiveBlocksPerMultiprocessor(&per_cu, (const void*)fwd_kernel, NTHR, LDS_BYTES) != hipSuccess || per_cu < 1) { fprintf(stderr, "kernel_launch: occupancy query says %d\n", per_cu); per_cu = 1; }
        (void)hipGetLastError();
        grid = cus * per_cu;
    }
    if (grid < 0) return;
    Params p{};
    p.x = (const float*)d_in[0]; p.meta = (const float*)d_in[1]; p.mixw = (const float*)d_in[2]; p.mlpw = (const float*)d_in[3]; p.awin = (const float*)d_in[4]; p.awout = (const float*)d_in[5];
    p.aqn = (const float*)d_in[6]; p.akn = (const float*)d_in[7]; p.asink = (const float*)d_in[8]; p.rwin = (const float*)d_in[9]; p.rwout = (const float*)d_in[10]; p.lbf = (const float*)d_in[11];
    p.lbb = (const float*)d_in[12]; p.rog = (const float*)d_in[13]; p.wup = (const float*)d_in[14]; p.wdn = (const float*)d_in[15];
    p.out = (float*)d_out; p.ws = (unsigned char*)d_ws;
#if N_LAUNCH_MODE == 1
#ifdef DBG_STOP
    p.ph_lo = 0; p.ph_hi = DBG_STOP;
#else
    p.ph_lo = 0; p.ph_hi = NPHASE;
#endif
    (void)hipMemsetAsync((char*)d_ws + OFF_BAR, 0, 256, stream);
    void* args[] = {&p};
    hipError_t e = hipLaunchCooperativeKernel((const void*)fwd_kernel, dim3(grid), dim3(NTHR), args, LDS_BYTES, stream);
    if (e != hipSuccess) fprintf(stderr, "cooperative launch failed: %s (grid %d)\n", hipGetErrorString(e), grid);
#else
    for (int ph = 0; ph < NPHASE; ++ph) { p.ph_lo = ph; p.ph_hi = ph + 1; hipLaunchKernelGGL(fwd_kernel, dim3(grid), dim3(NTHR), LDS_BYTES, stream, p); }
#endif
}
```

```cpp
#include <hip/hip_runtime.h>
#include <hip/hip_cooperative_groups.h>
#include <cstdio>
namespace cg = cooperative_groups;

#define DBG_SRC OFF_OB
#define PROBE_REP_SCAN 1
#define PROBE_REP_ATTN 1
#define LAS __attribute__((address_space(3)))
typedef unsigned short bf16_t;
typedef short bf16x8 __attribute__((ext_vector_type(8)));
typedef float f32x4 __attribute__((ext_vector_type(4)));
typedef float f32x2 __attribute__((ext_vector_type(2)));
typedef unsigned u32x4 __attribute__((ext_vector_type(4)));
typedef unsigned u32x2 __attribute__((ext_vector_type(2)));

constexpr int DM = 1024, NB = 8, SEQ = 8192, NMETA = 16;
constexpr int MREAL = NB * SEQ;
constexpr int MROWS = MREAL + NB * NMETA;
constexpr int MP = 65792;
constexpr int NTHR = 512;
constexpr int LDS_BYTES = 140 * 1024;
constexpr float EPS = 1e-6f;

constexpr size_t OFF_SQP = 0;
constexpr size_t OFF_LB = OFF_SQP + (size_t)MP * 16 * 4;
constexpr size_t OFF_ROPE = OFF_LB + 4 * 2 * 1024 * 4;
constexpr size_t OFF_HMETA = OFF_ROPE + (size_t)8208 * 64 * 8;
constexpr size_t OFF_WT = OFF_HMETA + (size_t)256 * 1024 * 4;
constexpr size_t WT_ELEMS = 51380224;
constexpr size_t OFF_HB = OFF_WT + WT_ELEMS * 2;
constexpr size_t OFF_OB = OFF_HB + (size_t)MP * 1024 * 2;
constexpr size_t OFF_BIG = OFF_OB + (size_t)MP * 1024 * 2;
constexpr size_t OFF_BAR = OFF_BIG + (size_t)MP * 5120 * 2;
constexpr size_t WS_END = OFF_BAR + 256;
static_assert(OFF_WT % 256 == 0 && OFF_HB % 256 == 0 && OFF_BIG % 256 == 0, "align");
__host__ __device__ constexpr size_t WT_AIN(int j) { return (size_t)j * 1536 * 1024; }
__host__ __device__ constexpr size_t WT_AOUT(int j) { return 3145728 + (size_t)j * 1048576; }
__host__ __device__ constexpr size_t WT_RIN(int j) { return 5242880 + (size_t)j * 5242880; }
__host__ __device__ constexpr size_t WT_ROUT(int j) { return 15728640 + (size_t)j * 1048576; }
__host__ __device__ constexpr size_t WT_UP(int l) { return 17825792 + (size_t)l * 4194304; }
__host__ __device__ constexpr size_t WT_DN(int l) { return 34603008 + (size_t)l * 4194304; }
constexpr size_t BIG_QP = (size_t)MP * 1536;
constexpr size_t BIG_KP = BIG_QP + (size_t)MP * 1024;
constexpr size_t BIG_VTR = BIG_KP + (size_t)MP * 256;
constexpr size_t BIG_VTM = BIG_VTR + (size_t)NB * 2 * 128 * SEQ;

struct Params {
    const float* x; const float* meta; const float* mixw; const float* mlpw; const float* awin; const float* awout;
    const float* aqn; const float* akn; const float* asink; const float* rwin; const float* rwout; const float* lbf;
    const float* lbb; const float* rog; const float* wup; const float* wdn;
    float* out; unsigned char* ws; int ph_lo, ph_hi;
};

typedef __bf16 bf16v2 __attribute__((ext_vector_type(2)));
__device__ __forceinline__ unsigned cvt_pk_bf16(float lo, float hi) { const f32x2 v = {lo, hi}; return __builtin_bit_cast(unsigned, __builtin_convertvector(v, bf16v2)); }
__device__ __forceinline__ int tid_of(int wv) { int l; asm volatile("v_mbcnt_lo_u32_b32 %0, -1, 0\n\tv_mbcnt_hi_u32_b32 %0, -1, %0" : "=v"(l)); return wv * 64 + l; }
__device__ __forceinline__ float shx(float v, int lane, int mask) { return __int_as_float(__builtin_amdgcn_ds_bpermute((lane ^ mask) << 2, __float_as_int(v))); }
__device__ __forceinline__ float bflo(unsigned w) { return __uint_as_float(w << 16); }
__device__ __forceinline__ float bfhi(unsigned w) { return __uint_as_float(w & 0xffff0000u); }
__device__ __forceinline__ float silu_f(float v) { return v * __builtin_amdgcn_rcpf(1.0f + __expf(-v)); }

namespace pg8 {
constexpr int BM = 256, BK = 64, HALF = 128, HTB = HALF * BK * 2, STAGE_BYTES = 8 * HTB, NXCD = 8, WGM = 8;
__host__ __device__ __forceinline__ int lds_byte(int r, int c) { const int st = (r >> 4) * 2 + (c >> 5), rr = r & 15, cc = c & 31, ob = rr * 64 + cc * 2; return st * 1024 + (ob ^ (((ob >> 9) & 1) << 5)); }
__host__ __device__ __forceinline__ void stage_rc(int b, int& R, int& C) { const int st = b / 1024, sb = b % 1024, swz = sb ^ (((sb >> 9) & 1) << 5); R = (st >> 1) * 16 + swz / 64; C = (st & 1) * 32 + (swz % 64) / 2; }
__host__ __device__ __forceinline__ int perm32(int rho) { const int n = rho >> 4, i = rho & 15; return 8 * (i >> 2) + 4 * n + (i & 3); }
struct Unit { int pm, pn; };
struct Gemm { const bf16_t* A; const bf16_t* Bt; int M, N, K; };
struct StaticOrder {
    int nM, nN, nwg, G, c, rev;
    __device__ void init(int M, int N, int G_, int c_, int rev_ = 0) { nM = M / BM; nN = N / BM; nwg = nM * nN; G = G_; c = c_; rev = rev_; }
    __device__ bool next(int i, Unit& u) const {
        const long L = (long)i * G + c; if (L >= nwg) return false;
        int wgid = (int)L; { const int q = nwg / NXCD, r = nwg % NXCD, xcd = wgid % NXCD, off = wgid / NXCD; wgid = (xcd < r ? xcd * (q + 1) : r * (q + 1) + (xcd - r) * q) + off; }
        const int nig = WGM * nN, gid = wgid / nig, fm = gid * WGM, gsz = (nM - fm) < WGM ? (nM - fm) : WGM;
        u.pm = fm + ((wgid % nig) % gsz); u.pn = (wgid % nig) / gsz; if (rev) u.pm = nM - 1 - u.pm; return true;
    }
};

template <class Epi>
__device__ __forceinline__ void gemm_phase(LAS unsigned char* lds, const Gemm g, const StaticOrder& S, const Epi& E, int wv) {
    const int tid = tid_of(wv), wid = __builtin_amdgcn_readfirstlane(tid >> 6), lane = tid & 63, wr = wid >> 2, wc = wid & 3, fr = lane & 15, fq = lane >> 4;
    const int K = g.K, nt = K / BK;
    unsigned voffA[2], voffB[2];
#pragma unroll
    for (int i = 0; i < 2; ++i) { int R, C; stage_rc(tid * 16 + i * 8192, R, C); const int Rb = Epi::PERM ? ((R & ~31) + perm32(R & 31)) : R;
        voffA[i] = (unsigned)(R * K + C) * 2u; voffB[i] = (unsigned)(Rb * K + C) * 2u; }
    const size_t kstep = (size_t)(BK * 2);
    const size_t hstep = (size_t)HALF * K * 2;
    const size_t tstep = 2 * hstep;
    const unsigned ldsw = (unsigned)wid * 1024u;
    const int aoff = lds_byte(wr * 64 + fr, fq * 8), boff = lds_byte(wc * 32 + fr, fq * 8);
#define PG8_SA(b, h) (((b) * 2 + (h)) * HTB)
#define PG8_SB(b, h) ((4 + (b) * 2 + (h)) * HTB)
#define PG8_STAGE(bufoff, gbase, voff) do { _Pragma("unroll") for (int _i = 0; _i < 2; ++_i) \
        __builtin_amdgcn_global_load_lds((const unsigned*)((const char*)(gbase) + (voff)[_i]), (LAS unsigned*)(lds + (bufoff) + ldsw + _i * 8192), 16, 0, 0); } while (0)
#define PG8_LDA(dst, b, h) do { _Pragma("unroll") for (int m = 0; m < 4; ++m) _Pragma("unroll") for (int k = 0; k < 2; ++k) dst[m][k] = *(const LAS bf16x8*)(lds + PG8_SA(b, h) + aoff + m * 2048 + k * 1024); } while (0)
#define PG8_LDB(dst, b, h) do { _Pragma("unroll") for (int n = 0; n < 2; ++n) _Pragma("unroll") for (int k = 0; k < 2; ++k) dst[n][k] = *(const LAS bf16x8*)(lds + PG8_SB(b, h) + boff + n * 2048 + k * 1024); } while (0)
#define PG8_MMA(ai, bj, At, Bt) do { __builtin_amdgcn_s_setprio(1); _Pragma("unroll") for (int m = 0; m < 4; ++m) _Pragma("unroll") for (int n = 0; n < 2; ++n) _Pragma("unroll") for (int k = 0; k < 2; ++k) \
        acc[ai][bj][m][n] = __builtin_amdgcn_mfma_f32_16x16x32_bf16(Bt[n][k], At[m][k], acc[ai][bj][m][n], 0, 0, 0); __builtin_amdgcn_s_setprio(0); } while (0)
#define PG8_WAIT_V(n) asm volatile("s_waitcnt vmcnt(" #n ")" ::: "memory")
#define PG8_WAIT_L(n) asm volatile("s_waitcnt lgkmcnt(" #n ")" ::: "memory")
#define PG8_BAR __builtin_amdgcn_s_barrier()
#define PG8_SCHED __builtin_amdgcn_sched_barrier(0)
    Unit cur, nxt; int ui = 0;
    if (!S.next(0, cur)) return;
    f32x4 acc[2][2][4][2];
#pragma unroll
    for (int a = 0; a < 2; ++a)
#pragma unroll
        for (int b = 0; b < 2; ++b)
#pragma unroll
            for (int m = 0; m < 4; ++m)
#pragma unroll
                for (int n = 0; n < 2; ++n) acc[a][b][m][n] = (f32x4){0.f, 0.f, 0.f, 0.f};
    bf16x8 At[4][2], B0[2][2], B1[2][2];
    const char* cA = (const char*)g.A + (size_t)cur.pm * tstep; const char* cB = (const char*)g.Bt + (size_t)cur.pn * tstep;
    PG8_STAGE(PG8_SB(0, 0), cB, voffB); PG8_STAGE(PG8_SB(0, 1), cB + hstep, voffB); PG8_STAGE(PG8_SA(0, 0), cA, voffA); PG8_STAGE(PG8_SA(0, 1), cA + hstep, voffA);
    if (wr == 1) PG8_BAR;
    PG8_WAIT_V(2); PG8_BAR;
    PG8_STAGE(PG8_SB(1, 0), cB + kstep, voffB); PG8_STAGE(PG8_SA(1, 0), cA + kstep, voffA); PG8_STAGE(PG8_SB(1, 1), cB + hstep + kstep, voffB);
    PG8_WAIT_V(6); PG8_BAR;
    for (;;) {
        const bool has_next = S.next(ui + 1, nxt);
        const char* nA = has_next ? (const char*)g.A + (size_t)nxt.pm * tstep : cA; const char* nB = has_next ? (const char*)g.Bt + (size_t)nxt.pn * tstep : cB;
        for (int t = 0; t < nt; t += 2) {
            const bool last = (t == nt - 2);
            const char* a1 = cA + (size_t)(t + 1) * kstep;
            const char* a2 = last ? nA : cA + (size_t)(t + 2) * kstep; const char* b2 = last ? nB : cB + (size_t)(t + 2) * kstep;
            const char* a3 = a2 + kstep; const char* b3 = b2 + kstep;
            PG8_LDB(B0, 0, 0); PG8_LDB(B1, 0, 1); PG8_SCHED; PG8_LDA(At, 0, 0); PG8_STAGE(PG8_SA(1, 1), a1 + hstep, voffA);
            PG8_WAIT_V(8); PG8_WAIT_L(0); PG8_BAR; PG8_MMA(0, 0, At, B0); PG8_MMA(0, 1, At, B1); PG8_BAR; PG8_SCHED;
            PG8_LDA(At, 0, 1); PG8_STAGE(PG8_SB(0, 0), b2, voffB); PG8_STAGE(PG8_SB(0, 1), b2 + hstep, voffB); PG8_STAGE(PG8_SA(0, 0), a2, voffA);
            PG8_WAIT_V(8); PG8_WAIT_L(0); PG8_BAR; PG8_MMA(1, 0, At, B0); PG8_MMA(1, 1, At, B1); PG8_BAR; PG8_SCHED;
            PG8_LDB(B0, 1, 0); PG8_LDB(B1, 1, 1); PG8_SCHED; PG8_LDA(At, 1, 0); PG8_STAGE(PG8_SA(0, 1), a2 + hstep, voffA);
            PG8_WAIT_V(8); PG8_WAIT_L(0); PG8_BAR; PG8_MMA(0, 0, At, B0); PG8_MMA(0, 1, At, B1); PG8_BAR; PG8_SCHED;
            PG8_LDA(At, 1, 1); PG8_STAGE(PG8_SB(1, 0), b3, voffB); PG8_STAGE(PG8_SB(1, 1), b3 + hstep, voffB); PG8_STAGE(PG8_SA(1, 0), a3, voffA);
            PG8_WAIT_V(8); PG8_WAIT_L(0); PG8_BAR; PG8_MMA(1, 0, At, B0); PG8_MMA(1, 1, At, B1); PG8_BAR; PG8_SCHED;
        }
        if (wr == 0) PG8_BAR;
        E(acc, cur, wr, wc, fr, fq);
        if (!has_next) break;
#pragma unroll
        for (int a = 0; a < 2; ++a)
#pragma unroll
            for (int b = 0; b < 2; ++b)
#pragma unroll
                for (int m = 0; m < 4; ++m)
#pragma unroll
                    for (int n = 0; n < 2; ++n) acc[a][b][m][n] = (f32x4){0.f, 0.f, 0.f, 0.f};
        cur = nxt; cA = nA; cB = nB; ++ui;
        if (wr == 1) PG8_BAR;
    }
    PG8_WAIT_V(0);
    PG8_BAR;
#undef PG8_SA
#undef PG8_SB
#undef PG8_STAGE
#undef PG8_LDA
#undef PG8_LDB
#undef PG8_MMA
#undef PG8_WAIT_V
#undef PG8_WAIT_L
#undef PG8_BAR
#undef PG8_SCHED
}
}

template <int ACT> struct EpiAct {
    static constexpr bool PERM = true;
    bf16_t* O; int ldc; const float* sq; const float* lbf; const float* lbb;
    __device__ __forceinline__ void operator()(const f32x4 (&acc)[2][2][4][2], const pg8::Unit& u, int wr, int wc, int fr, int fq) const {
        const int row0 = u.pm * 256 + wr * 64 + fr, col0 = u.pn * 256 + wc * 32 + 8 * fq;
        const int sect = (ACT == 2) ? (u.pn >> 2) : 0;
        f32x4 lbv[2][2];
#pragma unroll
        for (int bj = 0; bj < 2; ++bj) { lbv[bj][0] = (f32x4){0.f, 0.f, 0.f, 0.f}; lbv[bj][1] = lbv[bj][0]; }
        if (ACT == 2 && (sect == 2 || sect == 3)) { const float* lb = (sect == 2) ? lbf : lbb;
#pragma unroll
            for (int bj = 0; bj < 2; ++bj) { const int c = (col0 + bj * 128) & 1023; lbv[bj][0] = *(const f32x4*)(lb + c); lbv[bj][1] = *(const f32x4*)(lb + c + 4); } }
        float rsv[8];
        { f32x4 qv[8];
#pragma unroll
          for (int k = 0; k < 8; ++k) qv[k] = *(const f32x4*)(sq + (size_t)(row0 + (k >> 2) * 128 + (k & 3) * 16) * 16 + 4 * fq);
#pragma unroll
          for (int k = 0; k < 8; ++k) { float t = (qv[k][0] + qv[k][1]) + (qv[k][2] + qv[k][3]); t += shx(t, fq * 16 + fr, 16); t += shx(t, fq * 16 + fr, 32); rsv[k] = rsqrtf(t * (1.0f / 1024.0f) + EPS); } }
#pragma unroll
        for (int ai = 0; ai < 2; ++ai)
#pragma unroll
            for (int m = 0; m < 4; ++m) {
                const int row = row0 + ai * 128 + m * 16;
                const float rs = rsv[ai * 4 + m];
                bf16_t* rowp = O + (size_t)row * ldc + col0;
#pragma unroll
                for (int bj = 0; bj < 2; ++bj) {
                    float v[8];
#pragma unroll
                    for (int j = 0; j < 4; ++j) { v[j] = acc[ai][bj][m][0][j] * rs; v[4 + j] = acc[ai][bj][m][1][j] * rs; }
                    if (ACT == 1) {
#pragma unroll
                        for (int j = 0; j < 8; ++j) { const float t = fmaxf(v[j], 0.f); v[j] = t * t; }
                    }
                    if (ACT == 2) {
                        if (sect == 0 || sect == 4) {
#pragma unroll
                            for (int j = 0; j < 8; ++j) v[j] = silu_f(v[j]);
                        } else if (sect >= 2) {
#pragma unroll
                            for (int j = 0; j < 8; ++j) { const float lb = lbv[bj][j >> 2][j & 3]; const float sg = __builtin_amdgcn_rcpf(1.0f + __expf(-v[j])); v[j] = __log2f(lb + (1.0f - lb) * sg); }
                        }
                    }
                    u32x4 w; w.x = cvt_pk_bf16(v[0], v[1]); w.y = cvt_pk_bf16(v[2], v[3]); w.z = cvt_pk_bf16(v[4], v[5]); w.w = cvt_pk_bf16(v[6], v[7]);
                    *(u32x4*)(rowp + bj * 128) = w;
                }
            }
    }
};
struct EpiRes {
    static constexpr bool PERM = false;
    const float* rin; float* hout; float* hmeta; bf16_t* hb; float* sqn;
    __device__ __forceinline__ void operator()(const f32x4 (&acc)[2][2][4][2], const pg8::Unit& u, int wr, int wc, int fr, int fq) const {
        const bool mt = (u.pm == 256);
        const float* rbase = mt ? hmeta : rin; float* obase = mt ? hmeta : hout; const int rowoff = mt ? MREAL : 0;
        const int row0 = u.pm * 256 + wr * 64 + fr, col0 = u.pn * 256 + wc * 32 + 4 * fq;
#pragma unroll
        for (int ai = 0; ai < 2; ++ai)
#pragma unroll
            for (int m = 0; m < 4; ++m) {
                const int row = row0 + ai * 128 + m * 16; const size_t lo = (size_t)(row - rowoff) * 1024 + col0;
                float ss = 0.f;
#pragma unroll
                for (int bj = 0; bj < 2; ++bj)
#pragma unroll
                    for (int n = 0; n < 2; ++n) {
                        const int co = bj * 128 + n * 16;
                        const f32x4 r = *(const f32x4*)(rbase + lo + co); const f32x4 o = r + acc[ai][bj][m][n];
                        __builtin_nontemporal_store(o, (f32x4*)(obase + lo + co));
                        u32x2 w; w.x = cvt_pk_bf16(o[0], o[1]); w.y = cvt_pk_bf16(o[2], o[3]);
                        *(u32x2*)(hb + (size_t)row * 1024 + col0 + co) = w;
                        ss += (o[0] * o[0] + o[1] * o[1]) + (o[2] * o[2] + o[3] * o[3]);
                    }
                ss += shx(ss, fq * 16 + fr, 16); ss += shx(ss, fq * 16 + fr, 32);
                if (fq == 0) sqn[(size_t)row * 16 + u.pn * 4 + wc] = ss;
            }
    }
};

__device__ void transpose_w(const float* __restrict__ W, int K, int N, const float* __restrict__ scale, bf16_t* __restrict__ Wt, LAS float* tile, int wv) {
    const int tid = tid_of(wv); const int ntn = N >> 6, ntk = K >> 6;
    for (int t = blockIdx.x; t < ntn * ntk; t += gridDim.x) {
        const int tk = t / ntn, tn = t % ntn;
#pragma unroll
        for (int j = 0; j < 2; ++j) { const int kk = (tid >> 4) + 32 * j; const f32x4 v = *(const f32x4*)(W + (size_t)(tk * 64 + kk) * N + tn * 64 + (tid & 15) * 4);
            const float s = scale ? scale[tk * 64 + kk] : 1.0f;
#pragma unroll
            for (int i = 0; i < 4; ++i) tile[kk * 65 + (tid & 15) * 4 + i] = v[i] * s; }
        __syncthreads();
        { const int n = tid >> 3, k0 = (tid & 7) * 8; float v[8];
#pragma unroll
            for (int i = 0; i < 8; ++i) v[i] = tile[(k0 + i) * 65 + n];
            u32x4 w; w.x = cvt_pk_bf16(v[0], v[1]); w.y = cvt_pk_bf16(v[2], v[3]); w.z = cvt_pk_bf16(v[4], v[5]); w.w = cvt_pk_bf16(v[6], v[7]);
            *(u32x4*)(Wt + (size_t)(tn * 64 + n) * K + tk * 64 + k0) = w; }
        __syncthreads();
    }
}
__device__ __forceinline__ void sincos_d(double a, float& c, float& s) {
    const double k = rint(a * 0.63661977236758134308); const double r = fma(-k, 1.57079632679489655800, a) - k * 6.123233995736766e-17;
    const double r2 = r * r;
    const double sn = r * (1.0 + r2 * (-1.0 / 6 + r2 * (1.0 / 120 + r2 * (-1.0 / 5040 + r2 * (1.0 / 362880 + r2 * (-1.0 / 39916800 + r2 * (1.0 / 6227020800.0)))))));
    const double cs = 1.0 + r2 * (-0.5 + r2 * (1.0 / 24 + r2 * (-1.0 / 720 + r2 * (1.0 / 40320 + r2 * (-1.0 / 3628800 + r2 * (1.0 / 479001600.0))))));
    const int q = ((int)k) & 3;
    const double sv = (q == 0) ? sn : (q == 1) ? cs : (q == 2) ? -sn : -cs;
    const double cv = (q == 0) ? cs : (q == 1) ? -sn : (q == 2) ? -cs : sn;
    c = (float)cv; s = (float)sv;
}
__device__ void phase_init(const Params& p, LAS unsigned char* lds, int wv) {
    unsigned char* ws = p.ws; bf16_t* WT = (bf16_t*)(ws + OFF_WT); LAS float* tile = (LAS float*)lds;
    const int tid = tid_of(wv), lane = tid & 63, wave = tid >> 6;
    { float* LB = (float*)(ws + OFF_LB);
      for (int i = blockIdx.x * NTHR + tid; i < 2048; i += gridDim.x * NTHR) { const int dir = i >> 10, d = i & 1023; const float* T = dir ? p.lbb : p.lbf;
          const float t0 = T[d], t1 = T[1024 + d], t2 = T[2048 + d], t3 = T[3072 + d]; const float mx = fmaxf(fmaxf(t0, t1), fmaxf(t2, t3));
          const float e0 = expf(t0 - mx), e1 = expf(t1 - mx), e2 = expf(t2 - mx), e3 = expf(t3 - mx); const float inv = 1.0f / (e0 + e1 + e2 + e3);
          const float p1 = e1 * inv, p2 = e2 * inv, p3 = e3 * inv;
          LB[(0 * 2 + dir) * 1024 + d] = 0.f; LB[(1 * 2 + dir) * 1024 + d] = p1; LB[(2 * 2 + dir) * 1024 + d] = p1 + p2; LB[(3 * 2 + dir) * 1024 + d] = p1 + p2 + p3; }
      f32x2* RP = (f32x2*)(ws + OFF_ROPE);
      for (int i = blockIdx.x * NTHR + tid; i < 8208 * 64; i += gridDim.x * NTHR) { const int pos = i >> 6, fi = i & 63;
          const float inv = (float)exp(-(double)fi * (9.210340371976184 / 64.0)); const float ang = (float)pos * inv; float c, s; sincos_d((double)ang, c, s); RP[i] = (f32x2){c, s}; } }
    { bf16_t* HB = (bf16_t*)(ws + OFF_HB); float* SQP = (float*)(ws + OFF_SQP); float* HM = (float*)(ws + OFF_HMETA);
      for (int row = blockIdx.x * 8 + wave; row < MP; row += gridDim.x * 8) {
          const float* src = row < MREAL ? p.x + (size_t)row * 1024 : (row < MROWS ? p.meta + (size_t)((row - MREAL) & 15) * 1024 : nullptr);
          float ss = 0.f;
#pragma unroll
          for (int j = 0; j < 4; ++j) { const int c = j * 256 + lane * 4; f32x4 v = src ? *(const f32x4*)(src + c) : (f32x4){0.f, 0.f, 0.f, 0.f};
              ss += (v[0] * v[0] + v[1] * v[1]) + (v[2] * v[2] + v[3] * v[3]);
              u32x2 w; w.x = cvt_pk_bf16(v[0], v[1]); w.y = cvt_pk_bf16(v[2], v[3]); *(u32x2*)(HB + (size_t)row * 1024 + c) = w;
              if (row >= MREAL) *(f32x4*)(HM + (size_t)(row - MREAL) * 1024 + c) = v; }
#pragma unroll
          for (int o = 32; o >= 1; o >>= 1) ss += shx(ss, lane, o);
          if (lane < 16) SQP[(size_t)row * 16 + lane] = (lane == 0) ? ss : 0.f; } }
    for (int j = 0; j < 2; ++j) {
        transpose_w(p.awin + (size_t)j * 1024 * 1536, 1024, 1536, p.mixw + (2 * j) * 1024, WT + WT_AIN(j), tile, wv);
        transpose_w(p.awout + (size_t)j * 1024 * 1024, 1024, 1024, nullptr, WT + WT_AOUT(j), tile, wv);
        transpose_w(p.rwin + (size_t)j * 1024 * 5120, 1024, 5120, p.mixw + (2 * j + 1) * 1024, WT + WT_RIN(j), tile, wv);
        transpose_w(p.rwout + (size_t)j * 1024 * 1024, 1024, 1024, nullptr, WT + WT_ROUT(j), tile, wv);
    }
    for (int l = 0; l < 4; ++l) {
        transpose_w(p.wup + (size_t)l * 1024 * 4096, 1024, 4096, p.mlpw + l * 1024, WT + WT_UP(l), tile, wv);
        transpose_w(p.wdn + (size_t)l * 4096 * 1024, 4096, 1024, nullptr, WT + WT_DN(l), tile, wv);
    }
}

__device__ void phase_attn_prep(const Params& p, int j, LAS unsigned char* lds, int wv) {
    unsigned char* ws = p.ws; bf16_t* BIG = (bf16_t*)(ws + OFF_BIG);
    const bf16_t* QKV = BIG; bf16_t* Qp = BIG + BIG_QP; bf16_t* Kp = BIG + BIG_KP; bf16_t* VTr = BIG + BIG_VTR; bf16_t* VTm = BIG + BIG_VTM;
    const f32x2* RP = (const f32x2*)(ws + OFF_ROPE); const float* qg = p.aqn + j * 128; const float* kg = p.akn + j * 128;
    LAS bf16_t* tv = (LAS bf16_t*)lds;
    const int tid = tid_of(wv);
    for (int unit = blockIdx.x; unit < MROWS / 64; unit += gridDim.x) {
        const int row0 = unit * 64;
        for (int it0 = 0; it0 < 20; it0 += 4) {
          u32x2 lo4[4], hi4[4];
#pragma unroll
          for (int u = 0; u < 4; ++u) { const int task = (it0 + u) * 32 + (tid >> 4), r = task / 10, hd = task - r * 10, jj = tid & 15; const bf16_t* src = QKV + (size_t)(row0 + r) * 1536 + hd * 128;
              lo4[u] = *(const u32x2*)(src + 4 * jj); hi4[u] = *(const u32x2*)(src + 64 + 4 * jj); }
#pragma unroll
          for (int u = 0; u < 4; ++u) { const int it = it0 + u;
            const int task = it * 32 + (tid >> 4), r = task / 10, hd = task - r * 10, jj = tid & 15;
            const int row = row0 + r; const int pos = row < MREAL ? NMETA + (row & (SEQ - 1)) : ((row - MREAL) & 15);
            const u32x2 lo = lo4[u], hi = hi4[u];
            float x1[4] = {bflo(lo.x), bfhi(lo.x), bflo(lo.y), bfhi(lo.y)}, x2[4] = {bflo(hi.x), bfhi(hi.x), bflo(hi.y), bfhi(hi.y)};
            float ss = 0.f;
#pragma unroll
            for (int i = 0; i < 4; ++i) ss += x1[i] * x1[i] + x2[i] * x2[i];
            ss += shx(ss, tid & 63, 1); ss += shx(ss, tid & 63, 2); ss += shx(ss, tid & 63, 4); ss += shx(ss, tid & 63, 8);
            const float rs = rsqrtf(ss * (1.0f / 128.0f) + EPS);
            const float* gw = hd < 8 ? qg : kg; const float sc = hd < 8 ? 0.08838834764831845f * 1.4426950408889634f : 1.0f;
            const f32x4 g1 = *(const f32x4*)(gw + 4 * jj), g2 = *(const f32x4*)(gw + 64 + 4 * jj);
            float o1[4], o2[4];
#pragma unroll
            for (int i = 0; i < 4; ++i) { const f32x2 cs = RP[pos * 64 + 4 * jj + i]; const float y1 = x1[i] * rs * g1[i], y2 = x2[i] * rs * g2[i];
                o1[i] = (y1 * cs.x - y2 * cs.y) * sc; o2[i] = (y2 * cs.x + y1 * cs.y) * sc; }
            bf16_t* dst = hd < 8 ? Qp + (size_t)row * 1024 + hd * 128 : Kp + (size_t)row * 256 + (hd - 8) * 128;
            u32x2 w1, w2; w1.x = cvt_pk_bf16(o1[0], o1[1]); w1.y = cvt_pk_bf16(o1[2], o1[3]); w2.x = cvt_pk_bf16(o2[0], o2[1]); w2.y = cvt_pk_bf16(o2[2], o2[3]);
            *(u32x2*)(dst + 4 * jj) = w1; *(u32x2*)(dst + 64 + 4 * jj) = w2;
          }
        }
        { const int r = tid >> 3, c0 = (tid & 7) * 32; const bf16_t* src = QKV + (size_t)(row0 + r) * 1536 + 1280 + c0;
#pragma unroll
          for (int q = 0; q < 4; ++q) { const u32x4 v = *(const u32x4*)(src + q * 8); LAS unsigned* d = (LAS unsigned*)(tv + r * 258 + c0 + q * 8); d[0] = v.x; d[1] = v.y; d[2] = v.z; d[3] = v.w; } }
        __syncthreads();
#pragma unroll
        for (int it = 0; it < 4; ++it) { const int id = it * NTHR + tid, col = id >> 3, ch = id & 7; unsigned short e[8];
#pragma unroll
            for (int i = 0; i < 8; ++i) e[i] = tv[(ch * 8 + i) * 258 + col];
            u32x4 w; w.x = e[0] | ((unsigned)e[1] << 16); w.y = e[2] | ((unsigned)e[3] << 16); w.z = e[4] | ((unsigned)e[5] << 16); w.w = e[6] | ((unsigned)e[7] << 16);
            const int row = row0 + ch * 8, hkv = col >> 7, d = col & 127;
            bf16_t* dst; if (row < MREAL) { const int b = row >> 13, s = row & (SEQ - 1); dst = VTr + ((size_t)((b * 2 + hkv) * 128 + d)) * SEQ + s; }
            else { const int rr = row - MREAL, b = rr >> 4, m = rr & 15; dst = VTm + ((size_t)((b * 2 + hkv) * 128 + d)) * 16 + m; }
            *(u32x4*)dst = w; }
        __syncthreads();
    }
}

__device__ void phase_attn(const Params& p, int j, LAS unsigned char* lds, int wv) {
    unsigned char* ws = p.ws; bf16_t* BIG = (bf16_t*)(ws + OFF_BIG);
    const bf16_t* Qp = BIG + BIG_QP; const bf16_t* Kp = BIG + BIG_KP; const bf16_t* VTr = BIG + BIG_VTR; const bf16_t* VTm = BIG + BIG_VTM;
    bf16_t* OB = (bf16_t*)(ws + OFF_OB);
    constexpr int KSTR = 272, VSTR = 848;
    const int tid = tid_of(wv), w = __builtin_amdgcn_readfirstlane(tid >> 6), lane = tid & 63, m16 = lane & 15, g = lane >> 4;
    for (int item = blockIdx.x; item < 4096 + 64; item += gridDim.x) {
        int hq, b, n; bool real;
        if (item < 4096) { hq = item & 7; n = (item >> 3) & 63; b = item >> 9; real = true; } else { const int mi = item - 4096; hq = mi & 7; b = mi >> 3; n = 0; real = false; }
        const int hkv = hq >> 2; const int t0 = real ? (n - 1) * 128 : 0; const int nbg = real ? 12 : 4;
        const int mlo = real ? 0 : -1000000, mhi = real ? 256 : 112;
        const float sinkv = p.asink[j * 8 + hq] * 1.4426950408889634f;
        { u32x4 kb[13];
          const int c = (tid >> 4) & 31, jj = tid & 15, j8 = c >> 3, q = c & 7; const int lpos = (q < 4 ? 4 * j8 + q : 16 + 4 * j8 + (q - 4));
#pragma unroll
          for (int it = 0; it < 13; ++it) {
              const int slot = it * 32 + c; bool ok; const bf16_t* src;
              if (it < 12) { const int tok = t0 + slot; ok = (it < nbg) && tok >= 0 && tok < SEQ; src = Kp + (size_t)(b * SEQ + (ok ? tok : 0)) * 256 + hkv * 128 + 8 * jj; }
              else { ok = c < 16; src = Kp + (size_t)(MREAL + b * 16 + (c & 15)) * 256 + hkv * 128 + 8 * jj; }
              const u32x4 v = *(const u32x4*)src; kb[it] = ok ? v : (u32x4){0u, 0u, 0u, 0u};
          }
#pragma unroll
          for (int it = 0; it < 13; ++it) *(LAS u32x4*)(lds + (it * 32 + lpos) * KSTR + jj * 16) = kb[it];
        }
        const bool active = real || (w == 0);
        const int qrow = real ? b * SEQ + n * 128 + 16 * w + m16 : MREAL + b * 16 + m16;
        bf16x8 qf[4];
#pragma unroll
        for (int ks = 0; ks < 4; ++ks) qf[ks] = *(const bf16x8*)(Qp + (size_t)qrow * 1024 + hq * 128 + 32 * ks + 8 * g);
        __syncthreads();
        float s[13][8];
        const int a = real ? 16 * w + m16 : m16;
#pragma unroll
        for (int grp = 0; grp < 13; ++grp) {
            const bool use = active && ((grp < nbg && (!real || (grp * 32 + 31 >= 16 * w && grp * 32 <= 16 * w + 15 + 256))) || grp == 12);
            if (use) {
                f32x4 c0 = (f32x4){0.f, 0.f, 0.f, 0.f}, c1 = c0;
#pragma unroll
                for (int ks = 0; ks < 4; ++ks) {
                    const bf16x8 a0 = *(const LAS bf16x8*)(lds + (grp * 32 + m16) * KSTR + (32 * ks + 8 * g) * 2);
                    const bf16x8 a1 = *(const LAS bf16x8*)(lds + (grp * 32 + 16 + m16) * KSTR + (32 * ks + 8 * g) * 2);
                    c0 = __builtin_amdgcn_mfma_f32_16x16x32_bf16(a0, qf[ks], c0, 0, 0, 0);
                    c1 = __builtin_amdgcn_mfma_f32_16x16x32_bf16(a1, qf[ks], c1, 0, 0, 0);
                }
                const bool full = real && n >= 1 && n <= 62 && grp < 12 && (grp * 32 >= 16 * w + 15) && (grp * 32 + 31 <= 16 * w + 256);
#pragma unroll
                for (int r = 0; r < 8; ++r) {
                    const int c = 8 * g + r; const float v = r < 4 ? c0[r & 3] : c1[r & 3]; bool ok;
                    if (full) { s[grp][r] = v; continue; }
                    if (grp < 12) { const int slot = grp * 32 + c, tok = t0 + slot, rel = slot - a; ok = (tok >= 0) && (tok < SEQ) && (rel >= mlo) && (rel <= mhi); }
                    else ok = c < 16;
                    s[grp][r] = ok ? v : -1e30f;
                }
            } else {
#pragma unroll
                for (int r = 0; r < 8; ++r) s[grp][r] = -1e30f;
            }
        }
        float mx = sinkv;
#pragma unroll
        for (int grp = 0; grp < 13; ++grp)
#pragma unroll
            for (int r = 0; r < 8; ++r) mx = fmaxf(mx, s[grp][r]);
        mx = fmaxf(mx, shx(mx, lane, 16)); mx = fmaxf(mx, shx(mx, lane, 32));
        float sum = 0.f;
#pragma unroll
        for (int grp = 0; grp < 13; ++grp)
#pragma unroll
            for (int r = 0; r < 8; ++r) { const float e = __builtin_amdgcn_exp2f(s[grp][r] - mx); s[grp][r] = e; sum += e; }
        sum += shx(sum, lane, 16); sum += shx(sum, lane, 32);
        sum += __builtin_amdgcn_exp2f(sinkv - mx);
        const float inv = 1.0f / sum;
        bf16x8 pk[13];
#pragma unroll
        for (int grp = 0; grp < 13; ++grp) { u32x4 t; t.x = cvt_pk_bf16(s[grp][0], s[grp][1]); t.y = cvt_pk_bf16(s[grp][2], s[grp][3]);
            t.z = cvt_pk_bf16(s[grp][4], s[grp][5]); t.w = cvt_pk_bf16(s[grp][6], s[grp][7]); pk[grp] = __builtin_bit_cast(bf16x8, t); }
        __syncthreads();
#pragma unroll
        for (int hb = 0; hb < 2; ++hb) { u32x4 vb[7]; int t5 = tid; asm volatile("" : "+v"(t5));
#pragma unroll
          for (int i7 = 0; i7 < 7; ++i7) { const int it = hb * 7 + i7; if (it < 13) {
              const int id = it * NTHR + t5, d = id / 52, cc = id - d * 52; bool ok; const bf16_t* src;
              const size_t rowb = (size_t)((b * 2 + hkv) * 128 + d);
              if (cc < 48) { const int tok = t0 + cc * 8; ok = ((cc >> 2) < nbg) && tok >= 0 && tok < SEQ; src = VTr + rowb * SEQ + (ok ? tok : 0); }
              else { ok = cc < 50; src = VTm + rowb * 16 + (cc & 1) * 8; }
              const u32x4 v = *(const u32x4*)src; vb[i7] = ok ? v : (u32x4){0u, 0u, 0u, 0u}; } }
#pragma unroll
          for (int i7 = 0; i7 < 7; ++i7) { const int it = hb * 7 + i7; if (it < 13) { const int id = it * NTHR + t5, d = id / 52, cc = id - d * 52; *(LAS u32x4*)(lds + d * VSTR + cc * 16) = vb[i7]; } }
          asm volatile("" ::: "memory");
        }
        __syncthreads();
        if (active) {
            f32x4 o[8];
#pragma unroll
            for (int dt = 0; dt < 8; ++dt) o[dt] = (f32x4){0.f, 0.f, 0.f, 0.f};
#pragma unroll
            for (int grp = 0; grp < 13; ++grp) {
                if ((grp < nbg && (!real || (grp * 32 + 31 >= 16 * w && grp * 32 <= 16 * w + 15 + 256))) || grp == 12) {
#pragma unroll
                    for (int dt = 0; dt < 8; ++dt) { const bf16x8 av = *(const LAS bf16x8*)(lds + (16 * dt + m16) * VSTR + (grp * 32 + 8 * g) * 2);
                        o[dt] = __builtin_amdgcn_mfma_f32_16x16x32_bf16(av, pk[grp], o[dt], 0, 0, 0); }
                }
            }
            bf16_t* dst = OB + (size_t)qrow * 1024 + hq * 128 + 4 * g;
#pragma unroll
            for (int dt = 0; dt < 8; ++dt) { u32x2 wv; wv.x = cvt_pk_bf16(o[dt][0] * inv, o[dt][1] * inv); wv.y = cvt_pk_bf16(o[dt][2] * inv, o[dt][3] * inv); *(u32x2*)(dst + 16 * dt) = wv; }
        }
        __syncthreads();
    }
}

typedef short bf16x4 __attribute__((ext_vector_type(4)));
#define SC_BAR() do { asm volatile("s_waitcnt lgkmcnt(0)" ::: "memory"); __builtin_amdgcn_s_barrier(); asm volatile("" ::: "memory"); } while (0)
__device__ void phase_scan(const Params& p, LAS unsigned char* lds, int wv) {
    unsigned char* ws = p.ws; const bf16_t* P = (const bf16_t*)(ws + OFF_BIG); bf16_t* OF = (bf16_t*)(ws + OFF_HB); bf16_t* OBk = (bf16_t*)(ws + OFF_OB);
    const int tid = tid_of(wv), w = wv, lane = tid & 63, m16 = lane & 15, g = lane >> 4;
    constexpr int NCH = 1 + SEQ / 16, RING = 4, SLOT = 10240;
    constexpr int QSTR = 272, TSTR = 40, OSTR = 144;
    constexpr int OPB = 2 * 16 * QSTR + 128 * TSTR + 512;
    LAS unsigned char* QH = lds;
    LAS unsigned char* ABUF = lds + 2 * OPB + (w & 3) * 512;
    LAS unsigned char* OBUF0 = lds + 2 * OPB + 4 * 512;
    LAS unsigned char* RINGB = OBUF0 + 2 * 16 * OSTR;
    for (int item = blockIdx.x; item < 256; item += gridDim.x) {
        int half, rest;
        if (gridDim.x == 256) { const int sidx = item >> 3; half = sidx & 1; rest = (sidx >> 1) * 8 + (item & 7); } else { half = item & 1; rest = item >> 1; }
        const int dir = rest & 1, h = (rest >> 1) & 7, b = rest >> 4, dvb = 64 * half;
        bf16_t* dstb = dir ? OBk : OF;
        f32x4 S[8]; bf16x4 Sb[8];
#pragma unroll
        for (int j = 0; j < 8; ++j) { S[j] = (f32x4){0.f, 0.f, 0.f, 0.f}; Sb[j] = (bf16x4){0, 0, 0, 0}; }
        auto chunk_base = [&](int ci) { const bool meta = dir ? (ci == NCH - 1) : (ci == 0); return meta ? MREAL + b * 16 : b * SEQ + (dir ? (NCH - 2 - ci) : (ci - 1)) * 16; };
        auto issue = [&](int ci) { LAS unsigned char* sl = RINGB + (ci & (RING - 1)) * SLOT; const int cb = chunk_base(ci);
            if (w >= 4) {
#pragma unroll
                for (int i = 0; i < 2; ++i) { const int blk = (w - 4) * 2 + i, a = blk >> 2, tok = (blk & 3) * 4 + (lane >> 4); const int row = cb + (dir ? 15 - tok : tok);
                    const int coff = (a == 0) ? 0 : 2048 + dir * 1024;
                    __builtin_amdgcn_global_load_lds((const unsigned*)(P + (size_t)row * 5120 + h * 128 + coff + 8 * (lane & 15)), (LAS unsigned*)(sl + a * 4096 + (blk & 3) * 1024), 16, 0, 0); }
            } else if (w < 2) { const int tok = 8 * w + (lane >> 3); const int row = cb + (dir ? 15 - tok : tok);
                __builtin_amdgcn_global_load_lds((const unsigned*)(P + (size_t)row * 5120 + 1024 + h * 128 + dvb + 8 * (lane & 7)), (LAS unsigned*)(sl + 8192 + w * 1024), 16, 0, 0); } };
        auto store_out = [&](int cprev) { if (w == 2 || w == 3) { const LAS unsigned char* ob = OBUF0 + (cprev & 1) * 16 * OSTR; const int cb = chunk_base(cprev);
            const int sp = (w - 2) * 64 + lane, stok = sp >> 3, slj = sp & 7; const u32x4 ov = *(const LAS u32x4*)(ob + stok * OSTR + slj * 16);
            const int row = cb + (dir ? 15 - stok : stok); *(u32x4*)(dstb + (size_t)row * 1024 + h * 128 + dvb + 8 * slj) = ov; } };
        auto prep = [&](int cn) { const LAS unsigned char* RQn = RINGB + (cn & (RING - 1)) * SLOT; const LAS unsigned char* RGn = RQn + 4096;
            LAS unsigned char* QHn = QH + (cn & 1) * OPB; LAS unsigned char* KTn = QHn + 16 * QSTR; LAS unsigned char* KTTn = KTn + 16 * QSTR; LAS float* DECn = (LAS float*)(KTTn + 128 * TSTR);
            const int pt = tid - 256, dkp = pt & 63, tg = pt >> 6, dk = 2 * dkp;
            const int pos = (dk & ~31) + 8 * ((dk >> 2) & 3) + 4 * ((dk >> 4) & 1) + (dk & 3);
            float G0 = 0.f, G1 = 0.f;
            { unsigned gp[12];
#pragma unroll
              for (int t = 0; t < 12; ++t) gp[t] = *(const LAS unsigned*)(RGn + (t * 128 + dk) * 2);
#pragma unroll
              for (int t = 0; t < 12; ++t) { G0 += (t < 4 * tg) ? bflo(gp[t]) : 0.f; G1 += (t < 4 * tg) ? bfhi(gp[t]) : 0.f; } }
            float E0 = __builtin_amdgcn_exp2f(G0), E1 = __builtin_amdgcn_exp2f(G1);
            unsigned k0[4], k1[4];
#pragma unroll
            for (int i = 0; i < 4; ++i) { const int t = 4 * tg + i; const unsigned gw = *(const LAS unsigned*)(RGn + (t * 128 + dk) * 2), qw = *(const LAS unsigned*)(RQn + (t * 128 + dk) * 2);
                const float g0 = bflo(gw), g1 = bfhi(gw); G0 += g0; G1 += g1;
                const float f0 = __builtin_amdgcn_exp2f(g0), f1 = __builtin_amdgcn_exp2f(g1); E0 *= f0; E1 *= f1;
                const float qh0 = bflo(qw) * E0, qh1 = bfhi(qw) * E1;
                const float kt0 = (1.0f - f0) * __builtin_amdgcn_exp2f(fminf(-G0, 115.0f)), kt1 = (1.0f - f1) * __builtin_amdgcn_exp2f(fminf(-G1, 115.0f));
                const unsigned pq = cvt_pk_bf16(qh0, qh1), pk = cvt_pk_bf16(kt0, kt1);
                *(LAS unsigned*)(QHn + t * QSTR + pos * 2) = pq; *(LAS unsigned*)(KTn + t * QSTR + pos * 2) = pk; k0[i] = pk & 0xffffu; k1[i] = pk >> 16; }
            u32x2 kw0, kw1; kw0.x = k0[0] | (k0[1] << 16); kw0.y = k0[2] | (k0[3] << 16); kw1.x = k1[0] | (k1[1] << 16); kw1.y = k1[2] | (k1[3] << 16);
            *(LAS u32x2*)(KTTn + dk * TSTR + tg * 8) = kw0; *(LAS u32x2*)(KTTn + (dk + 1) * TSTR + tg * 8) = kw1;
            if (tg == 3) *(LAS f32x2*)(DECn + dk) = (f32x2){E0, E1}; };
        issue(0); issue(1); issue(2);
        if (w >= 4) asm volatile("s_waitcnt vmcnt(4)" ::: "memory");
        SC_BAR();
        if (w >= 4) prep(0);
        for (int ci = 0; ci < NCH; ++ci) {
            if (w >= 4 || w < 2) { if (ci + 2 < NCH) asm volatile("s_waitcnt vmcnt(2)" ::: "memory"); else asm volatile("s_waitcnt vmcnt(0)" ::: "memory"); }
            SC_BAR();
            if (ci > 0) store_out(ci - 1);
            if (ci + 3 < NCH) issue(ci + 3);
            if (w < 4) {
              const LAS unsigned char* RV = RINGB + (ci & (RING - 1)) * SLOT + 8192;
              LAS unsigned char* OBUF = OBUF0 + (ci & 1) * 16 * OSTR;
              LAS unsigned char* QHc = QH + (ci & 1) * OPB; LAS unsigned char* KTc = QHc + 16 * QSTR; LAS unsigned char* KTTc = KTc + 16 * QSTR; LAS float* DECc = (LAS float*)(KTTc + 128 * TSTR);
              bf16x8 qa[4]; f32x4 am = (f32x4){0.f, 0.f, 0.f, 0.f};
#pragma unroll
              for (int ks = 0; ks < 4; ++ks) { qa[ks] = *(const LAS bf16x8*)(QHc + m16 * QSTR + (32 * ks + 8 * g) * 2); const bf16x8 kb = *(const LAS bf16x8*)(KTc + m16 * QSTR + (32 * ks + 8 * g) * 2);
                  am = __builtin_amdgcn_mfma_f32_16x16x32_bf16(qa[ks], kb, am, 0, 0, 0); }
#pragma unroll
              for (int r = 0; r < 4; ++r) { const float v = (m16 <= 4 * g + r) ? am[r] : 0.f; const unsigned pv = cvt_pk_bf16(v, 0.f); *(LAS bf16_t*)(ABUF + (4 * g + r) * 32 + m16 * 2) = (bf16_t)(pv & 0xffffu); }
              bf16x4 vb;
              { unsigned e[4];
#pragma unroll
                for (int i = 0; i < 4; ++i) e[i] = *(const LAS bf16_t*)(RV + ((4 * g + i) * 64 + 16 * w + m16) * 2);
                u32x2 vw; vw.x = e[0] | (e[1] << 16); vw.y = e[2] | (e[3] << 16); vb = __builtin_bit_cast(bf16x4, vw); }
              f32x4 o = (f32x4){0.f, 0.f, 0.f, 0.f};
#pragma unroll
              for (int ks = 0; ks < 4; ++ks) { const bf16x8 sb = __builtin_shufflevector(Sb[2 * ks], Sb[2 * ks + 1], 0, 1, 2, 3, 4, 5, 6, 7); o = __builtin_amdgcn_mfma_f32_16x16x32_bf16(qa[ks], sb, o, 0, 0, 0); }
              { asm volatile("s_waitcnt lgkmcnt(0)" ::: "memory"); const bf16x4 aa = *(const LAS bf16x4*)(ABUF + m16 * 32 + 8 * g); o = __builtin_amdgcn_mfma_f32_16x16x16bf16_1k(aa, vb, o, 0, 0, 0); }
#pragma unroll
              for (int j = 0; j < 8; ++j) { const bf16x4 ka = *(const LAS bf16x4*)(KTTc + (16 * j + m16) * TSTR + 8 * g); S[j] = __builtin_amdgcn_mfma_f32_16x16x16bf16_1k(ka, vb, S[j], 0, 0, 0);
                  const f32x4 dc = *(const LAS f32x4*)(DECc + 16 * j + 4 * g); S[j] = S[j] * dc;
                  u32x2 sw; sw.x = cvt_pk_bf16(S[j][0], S[j][1]); sw.y = cvt_pk_bf16(S[j][2], S[j][3]); Sb[j] = __builtin_bit_cast(bf16x4, sw); }
#pragma unroll
              for (int r = 0; r < 4; ++r) { const unsigned pv = cvt_pk_bf16(o[r], 0.f); *(LAS bf16_t*)(OBUF + (4 * g + r) * OSTR + (16 * w + m16) * 2) = (bf16_t)(pv & 0xffffu); }
            } else if (ci + 1 < NCH) prep(ci + 1);
        }
        asm volatile("s_waitcnt vmcnt(0)" ::: "memory"); SC_BAR();
        store_out(NCH - 1);
        SC_BAR();
    }
}
__device__ void phase_rec_fin(const Params& p, int j, int wv) {
    unsigned char* ws = p.ws; const bf16_t* P = (const bf16_t*)(ws + OFF_BIG); const bf16_t* OF = (const bf16_t*)(ws + OFF_HB); bf16_t* OBk = (bf16_t*)(ws + OFF_OB);
    const float* og = p.rog + j * 128;
    const int tid = tid_of(wv), lj = tid & 15;
    const f32x4 g0 = *(const f32x4*)(og + 8 * lj), g1 = *(const f32x4*)(og + 8 * lj + 4);
    constexpr int NT = MROWS * 8;
    for (int task0 = blockIdx.x * 32 + (tid >> 4); task0 < NT; task0 += gridDim.x * 32 * 4) {
        u32x4 av[4], bv[4], sv4[4];
#pragma unroll
        for (int u = 0; u < 4; ++u) { const int task = task0 + u * gridDim.x * 32; const int tk = task < NT ? task : task0; const int row = tk >> 3, h = tk & 7; const size_t off = (size_t)row * 1024 + h * 128 + 8 * lj;
            av[u] = *(const u32x4*)(OF + off); bv[u] = *(const u32x4*)(OBk + off); sv4[u] = *(const u32x4*)(P + (size_t)row * 5120 + 4096 + h * 128 + 8 * lj); }
#pragma unroll
        for (int u = 0; u < 4; ++u) { const int task = task0 + u * gridDim.x * 32; if (task < NT) { const int row = task >> 3, h = task & 7; const size_t off = (size_t)row * 1024 + h * 128 + 8 * lj;
            const unsigned aa[4] = {av[u].x, av[u].y, av[u].z, av[u].w}, bb[4] = {bv[u].x, bv[u].y, bv[u].z, bv[u].w}, ss4[4] = {sv4[u].x, sv4[u].y, sv4[u].z, sv4[u].w};
            float x[8], sv[8]; float ss = 0.f;
#pragma unroll
            for (int i = 0; i < 4; ++i) { x[2 * i] = bflo(aa[i]) + bflo(bb[i]); x[2 * i + 1] = bfhi(aa[i]) + bfhi(bb[i]); sv[2 * i] = bflo(ss4[i]); sv[2 * i + 1] = bfhi(ss4[i]); ss += x[2 * i] * x[2 * i] + x[2 * i + 1] * x[2 * i + 1]; }
            ss += shx(ss, tid & 63, 1); ss += shx(ss, tid & 63, 2); ss += shx(ss, tid & 63, 4); ss += shx(ss, tid & 63, 8);
            const float rs = rsqrtf(ss * (1.0f / 128.0f) + EPS);
            float y[8];
#pragma unroll
            for (int i = 0; i < 8; ++i) y[i] = x[i] * rs * (i < 4 ? g0[i & 3] : g1[i & 3]) * sv[i];
            u32x4 wv4; wv4.x = cvt_pk_bf16(y[0], y[1]); wv4.y = cvt_pk_bf16(y[2], y[3]); wv4.z = cvt_pk_bf16(y[4], y[5]); wv4.w = cvt_pk_bf16(y[6], y[7]);
            *(u32x4*)(OBk + off) = wv4; } }
    }
}

__device__ __forceinline__ void fast_barrier(unsigned* ctr, unsigned& gen) {
    asm volatile("s_waitcnt vmcnt(0) lgkmcnt(0)" ::: "memory");
    __syncthreads();
    ++gen;
    if (threadIdx.x == 0) {
        __builtin_amdgcn_fence(__ATOMIC_RELEASE, "agent");
        asm volatile("s_waitcnt vmcnt(0)" ::: "memory");
        const unsigned target = gen * gridDim.x;
        (void)__hip_atomic_fetch_add(ctr, 1u, __ATOMIC_RELAXED, __HIP_MEMORY_SCOPE_AGENT);
        unsigned spins = 0;
        while (__hip_atomic_load(ctr, __ATOMIC_RELAXED, __HIP_MEMORY_SCOPE_AGENT) < target) { __builtin_amdgcn_s_sleep(1); if (++spins > (1u << 24)) break; }
        __builtin_amdgcn_fence(__ATOMIC_ACQUIRE, "agent");
        asm volatile("s_waitcnt vmcnt(0)" ::: "memory");
    }
    __syncthreads();
}

__device__ __forceinline__ void zero_f32(float* ptr, int n) { for (int i = blockIdx.x * NTHR + threadIdx.x; i < n; i += gridDim.x * NTHR) ptr[i] = 0.f; }

constexpr int NPHASE = 25;
__global__ void __launch_bounds__(NTHR, 2) fwd_kernel(Params p) {
    extern __shared__ __attribute__((aligned(16))) unsigned char lds_raw[];
    LAS unsigned char* lds = (LAS unsigned char*)lds_raw;
    cg::grid_group grid = cg::this_grid();
    const int wv = __builtin_amdgcn_readfirstlane(threadIdx.x >> 6);
    unsigned char* ws = p.ws;
    bf16_t* WT = (bf16_t*)(ws + OFF_WT); bf16_t* HB = (bf16_t*)(ws + OFF_HB); bf16_t* OB = (bf16_t*)(ws + OFF_OB); bf16_t* BIG = (bf16_t*)(ws + OFF_BIG);
    float* SQP = (float*)(ws + OFF_SQP); float* HM = (float*)(ws + OFF_HMETA); const float* LB = (const float*)(ws + OFF_LB);
    unsigned* BARC = (unsigned*)(ws + OFF_BAR); unsigned bgen = 0;
    int ph0 = p.ph_lo;
    if (p.ph_lo < 0) grid.sync();
    if (ph0 == 0) { phase_init(p, lds, wv); ph0 = 1; if (ph0 < p.ph_hi) fast_barrier(BARC, bgen); }
    for (int ph = ph0; ph < p.ph_hi; ++ph) {
        {
            const int L = (ph - 1) / 6, sub = (ph - 1) % 6, j = L >> 1; const bool isattn = !(L & 1);
            pg8::StaticOrder S;
            if (sub == 0) {
                if (isattn) { pg8::Gemm g{HB, WT + WT_AIN(j), MP, 1536, 1024}; S.init(MP, 1536, gridDim.x, blockIdx.x, 1); EpiAct<0> E{BIG, 1536, SQP, nullptr, nullptr}; pg8::gemm_phase<EpiAct<0>>(lds, g, S, E, wv); }
                else { pg8::Gemm g{HB, WT + WT_RIN(j), MP, 5120, 1024}; S.init(MP, 5120, gridDim.x, blockIdx.x, 1); EpiAct<2> E{BIG, 5120, SQP, LB + (L * 2 + 0) * 1024, LB + (L * 2 + 1) * 1024}; pg8::gemm_phase<EpiAct<2>>(lds, g, S, E, wv); }
            } else if (sub == 1) { if (isattn) phase_attn_prep(p, j, lds, wv); else {
#pragma unroll 1
                    for (int rep = 0; rep < PROBE_REP_SCAN; ++rep) { if (rep) grid.sync(); phase_scan(p, lds, wv); } } }
            else if (sub == 2) { if (isattn) {
#pragma unroll 1
                    for (int rep = 0; rep < PROBE_REP_ATTN; ++rep) { if (rep) grid.sync(); phase_attn(p, j, lds, wv); } } else phase_rec_fin(p, j, wv); }
            else if (sub == 4) {
                pg8::Gemm g{HB, WT + WT_UP(L), MP, 4096, 1024}; S.init(MP, 4096, gridDim.x, blockIdx.x, 1); EpiAct<1> E{BIG, 4096, SQP, nullptr, nullptr}; pg8::gemm_phase<EpiAct<1>>(lds, g, S, E, wv);
            } else {
                const bf16_t* A = (sub == 3) ? OB : BIG; const bf16_t* Bt = (sub == 3) ? (isattn ? WT + WT_AOUT(j) : WT + WT_ROUT(j)) : WT + WT_DN(L);
                const int K = (sub == 3) ? 1024 : 4096;
                pg8::Gemm g{A, Bt, MP, 1024, K}; S.init(MP, 1024, gridDim.x, blockIdx.x, 0);
                EpiRes E{(ph == 4) ? p.x : p.out, p.out, HM, HB, SQP};
                pg8::gemm_phase<EpiRes>(lds, g, S, E, wv);
            }
        }
        if (ph + 1 < p.ph_hi) fast_barrier(BARC, bgen);
    }
#ifdef DBG_STOP
    grid.sync();
    { const bf16_t* HBs = (const bf16_t*)(ws + DBG_SRC);
      for (size_t i = (size_t)blockIdx.x * NTHR + threadIdx.x; i < (size_t)MREAL * 1024; i += (size_t)gridDim.x * NTHR) p.out[i] = __uint_as_float(((unsigned)HBs[i]) << 16); }
#endif
}

#ifndef N_LAUNCH_MODE
#define N_LAUNCH_MODE 1
#endif
extern "C" void kernel_launch(void* const* d_in, const int* in_sizes, int n_in, void* d_out, int out_size, void* d_ws, size_t ws_size, hipStream_t stream) {
    static int grid = 0;
    if (grid == 0) {
        if (n_in != 16 || ws_size < WS_END) { fprintf(stderr, "kernel_launch: need 16 inputs and %zu bytes of workspace (got %d, %zu)\n", (size_t)WS_END, n_in, ws_size); grid = -1; return; }
        int dev = 0, cus = 0, per_cu = 0;
        (void)hipGetDevice(&dev); (void)hipDeviceGetAttribute(&cus, hipDeviceAttributeMultiprocessorCount, dev);
        if (hipFuncSetAttribute((const void*)fwd_kernel, hipFuncAttributeMaxDynamicSharedMemorySize, LDS_BYTES) != hipSuccess) { fprintf(stderr, "kernel_launch: hipFuncSetAttribute failed\n"); grid = -1; return; }
        if (hipOccupancyMaxActiveBlocksPerMultiprocessor(&per_cu, (const void*)fwd_kernel, NTHR, LDS_BYTES) != hipSuccess || per_cu < 1) { fprintf(stderr, "kernel_launch: occupancy query says %d\n", per_cu); per_cu = 1; }
        (void)hipGetLastError();
        grid = cus * per_cu;
    }
    if (grid < 0) return;
    Params p{};
    p.x = (const float*)d_in[0]; p.meta = (const float*)d_in[1]; p.mixw = (const float*)d_in[2]; p.mlpw = (const float*)d_in[3]; p.awin = (const float*)d_in[4]; p.awout = (const float*)d_in[5];
    p.aqn = (const float*)d_in[6]; p.akn = (const float*)d_in[7]; p.asink = (const float*)d_in[8]; p.rwin = (const float*)d_in[9]; p.rwout = (const float*)d_in[10]; p.lbf = (const float*)d_in[11];
    p.lbb = (const float*)d_in[12]; p.rog = (const float*)d_in[13]; p.wup = (const float*)d_in[14]; p.wdn = (const float*)d_in[15];
    p.out = (float*)d_out; p.ws = (unsigned char*)d_ws;
#if N_LAUNCH_MODE == 1
#ifdef DBG_STOP
    p.ph_lo = 0; p.ph_hi = DBG_STOP;
#else
    p.ph_lo = 0; p.ph_hi = NPHASE;
#endif
    (void)hipMemsetAsync((char*)d_ws + OFF_BAR, 0, 256, stream);
    void* args[] = {&p};
    hipError_t e = hipLaunchCooperativeKernel((const void*)fwd_kernel, dim3(grid), dim3(NTHR), args, LDS_BYTES, stream);
    if (e != hipSuccess) fprintf(stderr, "cooperative launch failed: %s (grid %d)\n", hipGetErrorString(e), grid);
#else
    for (int ph = 0; ph < NPHASE; ++ph) { p.ph_lo = ph; p.ph_hi = ph + 1; hipLaunchKernelGGL(fwd_kernel, dim3(grid), dim3(NTHR), LDS_BYTES, stream, p); }
#endif
}
```
